# Optimizing an MI355X kernel written in HIP

```python
import jax, jax.numpy as jnp
from jax import lax
import numpy as np

D_MODEL = 1024
BATCH = 8
SEQ = 2048
DEPTH = 4

D_FF = 2816
CONV_WIDTH = 31
POOL_WINDOWS = (2, 4, 8, 16)
N_POOL_GROUPS = len(POOL_WINDOWS)
POOL_GROUP = D_MODEL // N_POOL_GROUPS
N_MIXERS = 2
N_CONV_LAYERS = (DEPTH + 1) // 2
N_POOL_LAYERS = DEPTH // 2
EPS = 1e-6

kernel_name = "hybrid_conv_pool_macaron_trunk"


def rms_norm(x, g):
    xf = x.astype(jnp.float32)
    y = xf * lax.rsqrt(jnp.mean(xf * xf, axis=-1, keepdims=True) + EPS)
    return (y * g.astype(jnp.float32)).astype(x.dtype)


def layer_norm(x, g, b):
    xf = x.astype(jnp.float32)
    mu = jnp.mean(xf, axis=-1, keepdims=True)
    xc = xf - mu
    var = jnp.mean(xc * xc, axis=-1, keepdims=True)
    y = xc * lax.rsqrt(var + EPS) * g.astype(jnp.float32) + b.astype(jnp.float32)
    return y.astype(x.dtype)


def swiglu(h, w_gate, w_up, w_down):
    return (jax.nn.silu(h @ w_gate) * (h @ w_up)) @ w_down


def conv_module(h, w_in, b_in, dw, dw_b, ln_g, ln_b, w_out, b_out):
    u = h @ w_in + b_in
    a, gate = jnp.split(u, 2, axis=-1)
    v = a * jax.nn.sigmoid(gate)
    rhs = dw[:, None, :].astype(v.dtype)
    v = lax.conv_general_dilated(
        v, rhs, window_strides=(1,), padding=[(CONV_WIDTH - 1, 0)],
        dimension_numbers=("NWC", "WIO", "NWC"), feature_group_count=D_MODEL)
    v = v + dw_b
    v = layer_norm(v, ln_g, ln_b)
    v = jax.nn.silu(v)
    return v @ w_out + b_out


def pool_mixer(h, w_groups, scale):
    T = h.shape[1]
    hf = h.astype(jnp.float32)
    csum = jnp.cumsum(hf, axis=1)
    t_idx = jnp.arange(T)
    outs = []
    for g, w in enumerate(POOL_WINDOWS):
        sl = slice(g * POOL_GROUP, (g + 1) * POOL_GROUP)
        c = csum[:, :, sl]
        lagged = jnp.pad(c[:, :T - w], ((0, 0), (w, 0), (0, 0)))
        cnt = jnp.minimum(t_idx + 1, w).astype(jnp.float32)[None, :, None]
        pooled = (c - lagged) / cnt - hf[:, :, sl]
        outs.append(jnp.einsum("btc,cd->btd", pooled.astype(h.dtype), w_groups[g]))
    return jnp.concatenate(outs, axis=-1) * scale


def setup_inputs(seed: int = 0) -> dict:
    key = jax.random.key(seed)
    ks = jax.random.split(key, 20)
    f32 = jnp.float32
    D, F, K, Dg = D_MODEL, D_FF, CONV_WIDTH, POOL_GROUP
    nrm = lambda k, shape, s: jax.random.normal(k, shape, f32) * s
    x = jax.random.normal(ks[0], (BATCH, SEQ, D), f32)
    ffn_norm = 1.0 + nrm(ks[1], (DEPTH, 2, D), 0.02)
    ffn_w_gate = nrm(ks[2], (DEPTH, 2, D, F), D ** -0.5)
    ffn_w_up = nrm(ks[3], (DEPTH, 2, D, F), D ** -0.5)
    ffn_w_down = nrm(ks[4], (DEPTH, 2, F, D), F ** -0.5)
    mix_norm = 1.0 + nrm(ks[5], (DEPTH, D), 0.02)
    conv_w_in = nrm(ks[6], (N_CONV_LAYERS, D, 2 * D), D ** -0.5)
    conv_b_in = nrm(ks[7], (N_CONV_LAYERS, 2 * D), 0.02)
    conv_dw = nrm(ks[8], (N_CONV_LAYERS, K, D), K ** -0.5)
    conv_dw_b = nrm(ks[9], (N_CONV_LAYERS, D), 0.02)
    conv_ln_g = 1.0 + nrm(ks[10], (N_CONV_LAYERS, D), 0.02)
    conv_ln_b = nrm(ks[11], (N_CONV_LAYERS, D), 0.02)
    conv_w_out = nrm(ks[12], (N_CONV_LAYERS, D, D), D ** -0.5)
    conv_b_out = nrm(ks[13], (N_CONV_LAYERS, D), 0.02)
    pool_w = nrm(ks[14], (N_POOL_LAYERS, N_POOL_GROUPS, Dg, Dg), Dg ** -0.5)
    pool_scale = 1.0 + nrm(ks[15], (N_POOL_LAYERS, D), 0.02)
    final_norm = 1.0 + nrm(ks[16], (D,), 0.02)
    return {"x": x, "ffn_norm": ffn_norm, "ffn_w_gate": ffn_w_gate, "ffn_w_up": ffn_w_up,
            "ffn_w_down": ffn_w_down, "mix_norm": mix_norm, "conv_w_in": conv_w_in,
            "conv_b_in": conv_b_in, "conv_dw": conv_dw, "conv_dw_b": conv_dw_b,
            "conv_ln_g": conv_ln_g, "conv_ln_b": conv_ln_b, "conv_w_out": conv_w_out,
            "conv_b_out": conv_b_out, "pool_w": pool_w, "pool_scale": pool_scale,
            "final_norm": final_norm}


def reference(x, ffn_norm, ffn_w_gate, ffn_w_up, ffn_w_down, mix_norm, conv_w_in,
              conv_b_in, conv_dw, conv_dw_b, conv_ln_g, conv_ln_b, conv_w_out,
              conv_b_out, pool_w, pool_scale, final_norm):
    for i in range(DEPTH):
        x = x + 0.5 * swiglu(rms_norm(x, ffn_norm[i, 0]), ffn_w_gate[i, 0],
                             ffn_w_up[i, 0], ffn_w_down[i, 0])
        h = rms_norm(x, mix_norm[i])
        j = i // N_MIXERS
        if i % N_MIXERS == 0:
            x = x + conv_module(h, conv_w_in[j], conv_b_in[j], conv_dw[j], conv_dw_b[j],
                                conv_ln_g[j], conv_ln_b[j], conv_w_out[j], conv_b_out[j])
        else:
            x = x + pool_mixer(h, pool_w[j], pool_scale[j])
        x = x + 0.5 * swiglu(rms_norm(x, ffn_norm[i, 1]), ffn_w_gate[i, 1],
                             ffn_w_up[i, 1], ffn_w_down[i, 1])
    return rms_norm(x, final_norm)
```

```cpp
#include <hip/hip_runtime.h>
#include <hip/hip_cooperative_groups.h>
#include <cstdio>
#include <cstdint>
namespace cg = cooperative_groups;

#ifndef PROBE_MASK
#define PROBE_MASK 0
#endif
#ifndef MK_PER_PHASE
#define MK_PER_PHASE 0
#endif

#define GAS __attribute__((address_space(1)))
#define LAS __attribute__((address_space(3)))
typedef unsigned short bf16_t;
typedef short bf16x8 __attribute__((ext_vector_type(8)));
typedef float f32x4 __attribute__((ext_vector_type(4)));
typedef float f32x2 __attribute__((ext_vector_type(2)));
typedef unsigned u32x4 __attribute__((ext_vector_type(4)));
typedef unsigned u32x2 __attribute__((ext_vector_type(2)));

constexpr int D = 1024, FF = 2816, BATCH = 8, SEQ = 2048, M = BATCH * SEQ, DEPTH = 4, CONVW = 31;
constexpr float EPS = 1e-6f;
constexpr int NWAVES = 8;

constexpr size_t MiB = 1u << 20;
constexpr size_t WS_CTL = 0, CTL_ZERO_BYTES = 2 * MiB;
constexpr size_t WS_SSQ = 1 * MiB;
constexpr size_t WS_WGU = 2 * MiB;
constexpr size_t WS_WD = 90 * MiB;
constexpr size_t WS_WIN = 134 * MiB;
constexpr size_t WS_WOUT = 142 * MiB;
constexpr size_t WS_WP = 146 * MiB;
constexpr size_t WS_XB = 148 * MiB;
constexpr size_t WS_H = 180 * MiB;
constexpr size_t WS_V = 268 * MiB, WS_P = WS_V, WS_C = 300 * MiB;
constexpr size_t WS_END = 332 * MiB;
constexpr int CW_BAR = 4096;

constexpr int RING_BYTES = 131072;
constexpr int PRO_SCR_BYTES = 8 * 64 * 65 * 4;
constexpr int LDSCTL_OFF = 133120;
constexpr int LDS_BYTES = 134144;
static_assert(PRO_SCR_BYTES <= LDSCTL_OFF && LDSCTL_OFF % 16 == 0, "LDS map");

#define LDS_WAIT() asm volatile("s_waitcnt lgkmcnt(0)" ::: "memory")
#define VM_WAIT() asm volatile("s_waitcnt vmcnt(0)" ::: "memory")
typedef __bf16 bf16x2_t __attribute__((ext_vector_type(2)));
__device__ __forceinline__ unsigned cvt_pk_bf16(float lo, float hi) { const bf16x2_t b = __builtin_convertvector((f32x2){lo, hi}, bf16x2_t); return __builtin_bit_cast(unsigned, b); }
__device__ __forceinline__ float bf_lo(unsigned w) { return __builtin_bit_cast(float, w << 16); }
__device__ __forceinline__ float bf_hi(unsigned w) { return __builtin_bit_cast(float, w & 0xffff0000u); }
__device__ __forceinline__ float fast_sigmoid(float x) { return __builtin_amdgcn_rcpf(1.0f + __builtin_amdgcn_exp2f(-1.4426950408889634f * x)); }
__device__ __forceinline__ float wave_sum(float v) {
#pragma unroll
    for (int o = 1; o < 64; o <<= 1) v += __shfl_xor(v, o);
    return v;
}

namespace pg8 {
constexpr int BM = 256, BK = 64, HALF = 128, HTB = HALF * BK * 2  , STAGE_BYTES = 8 * HTB, NXCD = 8, WGM = 8;
__host__ __device__ __forceinline__ int lds_byte(int r, int c) { const int st = (r >> 4) * 2 + (c >> 5), rr = r & 15, cc = c & 31, ob = rr * 64 + cc * 2; return st * 1024 + (ob ^ (((ob >> 9) & 1) << 5)); }
__host__ __device__ __forceinline__ void stage_rc(int b, int& R, int& C) { const int st = b / 1024, sb = b % 1024, swz = sb ^ (((sb >> 9) & 1) << 5); R = (st >> 1) * 16 + swz / 64; C = (st & 1) * 32 + (swz % 64) / 2; }
__host__ __device__ __forceinline__ int perm32(int rho) { const int n = rho >> 4, i = rho & 15; return 8 * (i >> 2) + 4 * n + (i & 3); }

struct Unit { int pm, pn, half; };
struct Gemm { const bf16_t* A; const bf16_t* Bt; int lda, ldb, K, a_pn_bytes; };

struct StaticOrder {
    int nN, nfull, grp, rank;
    __device__ void init(int N_, int bx) { nN = N_ / BM; nfull = nN / 4; grp = bx & 7; rank = bx >> 3; }
    __device__ bool next(int i, Unit& u) const {
        const bool halves = (nN & 3) == 2;
        if (halves && (rank & 1)) { if (i == 0) { half_unit(u); return true; } --i; if (i < nfull) { full_unit(i, u); return true; } return false; }
        if (i < nfull) { full_unit(i, u); return true; }
        if (i == nfull && halves) { half_unit(u); return true; }
        return false;
    }
    __device__ void full_unit(int i, Unit& u) const { const int l = i * 32 + rank; u.pm = 8 * grp + (l & 7); u.pn = l >> 3; u.half = 0; }
    __device__ void half_unit(Unit& u) const { u.pn = 4 * nfull + (rank >> 4); u.pm = 8 * grp + ((rank & 15) >> 1); u.half = 1 + (rank & 1); }
};


struct EpiSwiGLU {
    bf16_t* H; int ldh; const float* ssq; bool skip;
    __device__ __forceinline__ void prefetch(const Unit& u, int wr, int lane, float (&pre)[2]) const {
        const int rb = u.pm * BM + (u.half == 2 ? HALF : 0) + wr * 64 + lane;
        pre[0] = ssq[rb]; pre[1] = ssq[rb + HALF];
    }
    __device__ __forceinline__ void operator()(const f32x4 (&acc)[2][2][4][2], const Unit& u, int wr, int wc, int fr, int fq, const float (&pre)[2]) const {
        if (skip) return;
        const int row0 = u.pm * BM + (u.half == 2 ? HALF : 0) + wr * 64 + fr, col0 = u.pn * HALF + wc * 32 + 8 * fq;
#pragma unroll
        for (int ai = 0; ai < 2; ++ai) {
            if (ai == 1 && u.half != 0) break;
            const float rl = __builtin_amdgcn_rsqf(pre[ai] * (1.0f / D) + EPS);
#pragma unroll
            for (int m = 0; m < 4; ++m) {
                const float r = __shfl(rl, m * 16 + fr);
                const float c1 = r * -1.4426950408889634f, r2 = r * r;
                f32x2 h[4];
#pragma unroll
                for (int n = 0; n < 2; ++n)
#pragma unroll
                    for (int jp = 0; jp < 2; ++jp) {
                        const f32x2 g = (f32x2){acc[ai][0][m][n][2 * jp], acc[ai][0][m][n][2 * jp + 1]}, up = (f32x2){acc[ai][1][m][n][2 * jp], acc[ai][1][m][n][2 * jp + 1]};
                        const f32x2 t = g * c1;
                        f32x2 e; e.x = __builtin_amdgcn_exp2f(t.x); e.y = __builtin_amdgcn_exp2f(t.y);
                        const f32x2 d = e + 1.0f;
                        f32x2 q; q.x = __builtin_amdgcn_rcpf(d.x); q.y = __builtin_amdgcn_rcpf(d.y);
                        h[2 * n + jp] = (g * up) * (q * r2);
                    }
                u32x4 w; w.x = cvt_pk_bf16(h[0].x, h[0].y); w.y = cvt_pk_bf16(h[1].x, h[1].y); w.z = cvt_pk_bf16(h[2].x, h[2].y); w.w = cvt_pk_bf16(h[3].x, h[3].y);
                *(u32x4*)(H + (size_t)(row0 + ai * HALF + m * 16) * ldh + col0) = w;
            }
        }
    }
};
struct EpiGLU {
    bf16_t* V; const float* ssq; const float* bias;
    __device__ __forceinline__ void prefetch(const Unit& u, int wr, int lane, float (&pre)[2]) const {
        const int rb = u.pm * BM + wr * 64 + lane;
        pre[0] = ssq[rb]; pre[1] = ssq[rb + HALF];
    }
    __device__ __forceinline__ void operator()(const f32x4 (&acc)[2][2][4][2], const Unit& u, int wr, int wc, int fr, int fq, const float (&pre)[2]) const {
        const int row0 = u.pm * BM + wr * 64 + fr, col0 = u.pn * HALF + wc * 32 + 8 * fq;
        f32x4 ba[2], bg[2];
#pragma unroll
        for (int n = 0; n < 2; ++n) { ba[n] = *(const f32x4*)(bias + col0 + 4 * n); bg[n] = *(const f32x4*)(bias + D + col0 + 4 * n); }
#pragma unroll
        for (int ai = 0; ai < 2; ++ai) {
            const float rl = __builtin_amdgcn_rsqf(pre[ai] * (1.0f / D) + EPS);
#pragma unroll
            for (int m = 0; m < 4; ++m) {
                const float r = __shfl(rl, m * 16 + fr);
                float h[8];
#pragma unroll
                for (int n = 0; n < 2; ++n)
#pragma unroll
                    for (int j = 0; j < 4; ++j) { const float a = acc[ai][0][m][n][j] * r + ba[n][j], g = acc[ai][1][m][n][j] * r + bg[n][j]; h[4 * n + j] = a * fast_sigmoid(g); }
                u32x4 w; w.x = cvt_pk_bf16(h[0], h[1]); w.y = cvt_pk_bf16(h[2], h[3]); w.z = cvt_pk_bf16(h[4], h[5]); w.w = cvt_pk_bf16(h[6], h[7]);
                *(u32x4*)(V + (size_t)(row0 + ai * HALF + m * 16) * D + col0) = w;
            }
        }
    }
};
struct EpiResid {
    const float* base; float* out; bf16_t* xb; const float* bias; float* ssq_out;
    __device__ __forceinline__ void prefetch(const Unit&, int, int, float (&pre)[2]) const { pre[0] = 0.f; pre[1] = 0.f; }
    __device__ __forceinline__ void operator()(const f32x4 (&acc)[2][2][4][2], const Unit& u, int wr, int wc, int fr, int fq, const float (&)[2]) const {
        const int row0 = u.pm * BM + wr * 64 + fr, col0 = u.pn * BM + wc * 32 + 8 * fq;
        f32x4 bv[2][2];
#pragma unroll
        for (int bj = 0; bj < 2; ++bj)
#pragma unroll
            for (int n = 0; n < 2; ++n) bv[bj][n] = bias ? *(const f32x4*)(bias + col0 + bj * HALF + 4 * n) : (f32x4){0.f, 0.f, 0.f, 0.f};
#pragma unroll
        for (int ai = 0; ai < 2; ++ai)
#pragma unroll
            for (int mp = 0; mp < 4; mp += 4) {
                f32x4 b[4][2][2];
#pragma unroll
                for (int mm = 0; mm < 4; ++mm)
#pragma unroll
                    for (int bj = 0; bj < 2; ++bj) { const size_t off = (size_t)(row0 + ai * HALF + (mp + mm) * 16) * D + col0 + bj * HALF;
                        b[mm][bj][0] = *(const f32x4*)(base + off); b[mm][bj][1] = *(const f32x4*)(base + off + 4); }
#pragma unroll
                for (int mm = 0; mm < 4; ++mm) {
                    const int m = mp + mm; const int row = row0 + ai * HALF + m * 16; const size_t off = (size_t)row * D + col0; float s = 0.f;
#pragma unroll
                    for (int bj = 0; bj < 2; ++bj) {
                        const f32x4 v0 = b[mm][bj][0] + acc[ai][bj][m][0] + bv[bj][0], v1 = b[mm][bj][1] + acc[ai][bj][m][1] + bv[bj][1];
                        *(f32x4*)(out + off + bj * HALF) = v0; *(f32x4*)(out + off + bj * HALF + 4) = v1;
                        u32x4 w; w.x = cvt_pk_bf16(v0[0], v0[1]); w.y = cvt_pk_bf16(v0[2], v0[3]); w.z = cvt_pk_bf16(v1[0], v1[1]); w.w = cvt_pk_bf16(v1[2], v1[3]);
                        if (xb) *(u32x4*)(xb + off + bj * HALF) = w;
                        s += (v0[0] * v0[0] + v0[1] * v0[1]) + (v0[2] * v0[2] + v0[3] * v0[3]) + (v1[0] * v1[0] + v1[1] * v1[1]) + (v1[2] * v1[2] + v1[3] * v1[3]);
                    }
                    s += __shfl_xor(s, 16); s += __shfl_xor(s, 32);
                    if (fq == 0) unsafeAtomicAdd(ssq_out + row, s);
                }
                asm volatile("" ::: "memory");
            }
    }
};
struct EpiFinal {
    const float* base; float* out; const float* gain; float* ssq_out; unsigned* pcnt; unsigned* tmo;
    __device__ __forceinline__ void prefetch(const Unit&, int, int, float (&pre)[2]) const { pre[0] = 0.f; pre[1] = 0.f; }
    __device__ __forceinline__ void operator()(f32x4 (&acc)[2][2][4][2], const Unit& u, int wr, int wc, int fr, int fq, const float (&)[2]) const {
        const int row0 = u.pm * BM + wr * 64 + fr, col0 = u.pn * BM + wc * 32 + 8 * fq;
#pragma unroll
        for (int ai = 0; ai < 2; ++ai)
#pragma unroll
            for (int mp = 0; mp < 4; mp += 4) {
                f32x4 b[4][2][2];
#pragma unroll
                for (int mm = 0; mm < 4; ++mm)
#pragma unroll
                    for (int bj = 0; bj < 2; ++bj) { const size_t off = (size_t)(row0 + ai * HALF + (mp + mm) * 16) * D + col0 + bj * HALF;
                        b[mm][bj][0] = *(const f32x4*)(base + off); b[mm][bj][1] = *(const f32x4*)(base + off + 4); }
#pragma unroll
                for (int mm = 0; mm < 4; ++mm) {
                    const int m = mp + mm; const int row = row0 + ai * HALF + m * 16; float s = 0.f;
#pragma unroll
                    for (int bj = 0; bj < 2; ++bj) {
                        const f32x4 v0 = b[mm][bj][0] + acc[ai][bj][m][0], v1 = b[mm][bj][1] + acc[ai][bj][m][1];
                        acc[ai][bj][m][0] = v0; acc[ai][bj][m][1] = v1;
                        s += (v0[0] * v0[0] + v0[1] * v0[1]) + (v0[2] * v0[2] + v0[3] * v0[3]) + (v1[0] * v1[0] + v1[1] * v1[1]) + (v1[2] * v1[2] + v1[3] * v1[3]);
                    }
                    s += __shfl_xor(s, 16); s += __shfl_xor(s, 32);
                    if (fq == 0) unsafeAtomicAdd(ssq_out + row, s);
                }
                asm volatile("" ::: "memory");
            }
        asm volatile("s_waitcnt vmcnt(0)" ::: "memory");
        unsigned* cnt = pcnt + 64 * u.pm;
        if ((threadIdx.x & 63) == 0) (void)__hip_atomic_fetch_add(cnt, 1u, __ATOMIC_RELAXED, __HIP_MEMORY_SCOPE_AGENT);
        { unsigned sp = 0;
          while ((unsigned)__builtin_amdgcn_readfirstlane((int)__hip_atomic_load(cnt, __ATOMIC_RELAXED, __HIP_MEMORY_SCOPE_AGENT)) < 32u) { __builtin_amdgcn_s_sleep(1);
              if ((++sp & 255u) == 0u) { if (__hip_atomic_load(tmo, __ATOMIC_RELAXED, __HIP_MEMORY_SCOPE_AGENT)) break; if (sp > (1u << 18)) { atomicAdd(tmo, 1u); break; } } } }
        f32x4 gv[2][2];
#pragma unroll
        for (int bj = 0; bj < 2; ++bj)
#pragma unroll
            for (int n = 0; n < 2; ++n) gv[bj][n] = *(const f32x4*)(gain + col0 + bj * HALF + 4 * n);
        float rs[2][4];
#pragma unroll
        for (int ai = 0; ai < 2; ++ai)
#pragma unroll
            for (int m = 0; m < 4; ++m) rs[ai][m] = __hip_atomic_load(ssq_out + row0 + ai * HALF + m * 16, __ATOMIC_RELAXED, __HIP_MEMORY_SCOPE_AGENT);
#pragma unroll
        for (int ai = 0; ai < 2; ++ai)
#pragma unroll
            for (int m = 0; m < 4; ++m) {
                const float r = __builtin_amdgcn_rsqf(rs[ai][m] * (1.0f / D) + EPS); const size_t off = (size_t)(row0 + ai * HALF + m * 16) * D + col0;
#pragma unroll
                for (int bj = 0; bj < 2; ++bj) {
                    __builtin_nontemporal_store(acc[ai][bj][m][0] * r * gv[bj][0], (f32x4*)(out + off + bj * HALF));
                    __builtin_nontemporal_store(acc[ai][bj][m][1] * r * gv[bj][1], (f32x4*)(out + off + bj * HALF + 4));
                }
            }
    }
};

template <class Epi, bool ALIGN_EPI, bool SP2 = false>
__device__ __forceinline__ void gemm_phase(LAS unsigned char* lds, const Gemm g, const StaticOrder& S, const Epi& E, const int tid) {
    const int wid = __builtin_amdgcn_readfirstlane(tid >> 6), lane = tid & 63, wr = wid >> 2, wc = wid & 3, fr = lane & 15, fq = lane >> 4;
    const int K = g.K, nt = K / BK;
    unsigned voffA[2], voffB[2];
#pragma unroll
    for (int i = 0; i < 2; ++i) { int R, C; stage_rc(tid * 16 + i * 8192, R, C); const int Rb = (R & ~31) + perm32(R & 31);
        voffA[i] = (unsigned)(R * g.lda + C) * 2u; voffB[i] = (unsigned)(Rb * g.ldb + C) * 2u; }
    const size_t kstep = (size_t)(BK * 2);
    const size_t hstepA = (size_t)HALF * g.lda * 2, hstepB = (size_t)HALF * g.ldb * 2;
    const size_t tstepA = 2 * hstepA, tstepB = 2 * hstepB;
    const unsigned ldsw = (unsigned)wid * 1024u;
    const int aoff = lds_byte(wr * 64 + fr, fq * 8), boff = lds_byte(wc * 32 + fr, fq * 8);
#define PG8_SA(b, h) (((b) * 2 + (h)) * HTB)
#define PG8_SB(b, h) ((4 + (b) * 2 + (h)) * HTB)
#define PG8_STAGE(bufoff, gbase, voff) do { _Pragma("unroll") for (int _i = 0; _i < 2; ++_i) \
        __builtin_amdgcn_global_load_lds((const unsigned*)((const char*)(gbase) + (voff)[_i]), (LAS unsigned*)(lds + (bufoff) + ldsw + _i * 8192), 16, 0, 0); } while (0)
#define PG8_LDA(dst, b, h) do { _Pragma("unroll") for (int m = 0; m < 4; ++m) _Pragma("unroll") for (int k = 0; k < 2; ++k) dst[m][k] = *(const LAS bf16x8*)(lds + PG8_SA(b, h) + aoff + m * 2048 + k * 1024); } while (0)
#define PG8_LDB(dst, b, h) do { _Pragma("unroll") for (int n = 0; n < 2; ++n) _Pragma("unroll") for (int k = 0; k < 2; ++k) dst[n][k] = *(const LAS bf16x8*)(lds + PG8_SB(b, h) + boff + n * 2048 + k * 1024); } while (0)
#define PG8_MMA(ai, bj, At, Bt) do { __builtin_amdgcn_s_setprio(1); _Pragma("unroll") for (int m = 0; m < 4; ++m) _Pragma("unroll") for (int n = 0; n < 2; ++n) _Pragma("unroll") for (int k = 0; k < 2; ++k) \
        acc[ai][bj][m][n] = __builtin_amdgcn_mfma_f32_16x16x32_bf16(Bt[n][k], At[m][k], acc[ai][bj][m][n], 0, 0, 0); __builtin_amdgcn_s_setprio(0); } while (0)
#define PG8_WAIT_V(n) asm volatile("s_waitcnt vmcnt(" #n ")" ::: "memory")
#define PG8_WAIT_L(n) asm volatile("s_waitcnt lgkmcnt(" #n ")" ::: "memory")
#define PG8_BAR __builtin_amdgcn_s_barrier()
#define PG8_SCHED __builtin_amdgcn_sched_barrier(0)
    Unit cur, nxt; int ui = 0;
    if (!S.next(0, cur)) return;
    f32x4 acc[2][2][4][2];
#pragma unroll
    for (int a = 0; a < 2; ++a)
#pragma unroll
        for (int b = 0; b < 2; ++b)
#pragma unroll
            for (int m = 0; m < 4; ++m)
#pragma unroll
                for (int n = 0; n < 2; ++n) acc[a][b][m][n] = (f32x4){0.f, 0.f, 0.f, 0.f};
    bf16x8 At[4][2], B0[2][2], B1[2][2];
    float pre[2]; E.prefetch(cur, wr, lane, pre);
    const char* cA = (const char*)g.A + (size_t)cur.pm * tstepA + (size_t)cur.pn * g.a_pn_bytes + (cur.half == 2 ? hstepA : (size_t)0); const char* cB = (const char*)g.Bt + (size_t)cur.pn * tstepB;
    if constexpr (SP2) {
    PG8_STAGE(PG8_SB(0, 0), cB, voffB); PG8_STAGE(PG8_SB(0, 1), cB + hstepB, voffB); PG8_STAGE(PG8_SA(0, 0), cA, voffA); PG8_STAGE(PG8_SA(0, 1), cA + hstepA, voffA);
    if (wr == 1) PG8_BAR;
    PG8_WAIT_V(2); PG8_BAR;
    PG8_STAGE(PG8_SB(1, 0), cB + kstep, voffB); PG8_STAGE(PG8_SA(1, 0), cA + kstep, voffA); PG8_STAGE(PG8_SB(1, 1), cB + hstepB + kstep, voffB);
    PG8_WAIT_V(6); PG8_BAR;
    } else {
    PG8_STAGE(PG8_SB(0, 0), cB, voffB); PG8_STAGE(PG8_SA(0, 0), cA, voffA); PG8_STAGE(PG8_SB(0, 1), cB + hstepB, voffB); PG8_STAGE(PG8_SA(0, 1), cA + hstepA, voffA);
    if (wr == 1) PG8_BAR;
    PG8_WAIT_V(4); PG8_BAR;
    PG8_STAGE(PG8_SB(1, 0), cB + kstep, voffB); PG8_STAGE(PG8_SA(1, 0), cA + kstep, voffA); PG8_STAGE(PG8_SB(1, 1), cB + hstepB + kstep, voffB);
    PG8_WAIT_V(6); PG8_BAR;
    }
    for (;;) {
        const bool has_next = S.next(ui + 1, nxt);
        const char* nA = has_next ? (const char*)g.A + (size_t)nxt.pm * tstepA + (size_t)nxt.pn * g.a_pn_bytes + (nxt.half == 2 ? hstepA : (size_t)0) : cA;
        const bool full = (cur.half == 0); const char* nB = has_next ? (const char*)g.Bt + (size_t)nxt.pn * tstepB : cB;
        for (int t = 0; t < nt; t += 2) {
            const bool last = (t == nt - 2);
            const char* a1 = cA + (size_t)(t + 1) * kstep;
            const char* a2 = last ? nA : cA + (size_t)(t + 2) * kstep; const char* b2 = last ? nB : cB + (size_t)(t + 2) * kstep;
            const char* a3 = a2 + kstep; const char* b3 = b2 + kstep;
            if constexpr (SP2) {
            PG8_LDB(B0, 0, 0); PG8_LDB(B1, 0, 1); PG8_SCHED; PG8_LDA(At, 0, 0); PG8_STAGE(PG8_SA(1, 1), a1 + hstepA, voffA);
            PG8_WAIT_V(8); PG8_WAIT_L(0); PG8_BAR; PG8_MMA(0, 0, At, B0); PG8_MMA(0, 1, At, B1); PG8_BAR; PG8_SCHED;
            if (full) PG8_LDA(At, 0, 1); PG8_STAGE(PG8_SB(0, 0), b2, voffB); PG8_STAGE(PG8_SB(0, 1), b2 + hstepB, voffB); PG8_STAGE(PG8_SA(0, 0), a2, voffA);
            PG8_WAIT_V(8); PG8_WAIT_L(0); PG8_BAR; if (full) { PG8_MMA(1, 0, At, B0); PG8_MMA(1, 1, At, B1); } PG8_BAR; PG8_SCHED;
            PG8_LDB(B0, 1, 0); PG8_LDB(B1, 1, 1); PG8_SCHED; PG8_LDA(At, 1, 0); PG8_STAGE(PG8_SA(0, 1), a2 + hstepA, voffA);
            PG8_WAIT_V(8); PG8_WAIT_L(0); PG8_BAR; PG8_MMA(0, 0, At, B0); PG8_MMA(0, 1, At, B1); PG8_BAR; PG8_SCHED;
            if (full) PG8_LDA(At, 1, 1); PG8_STAGE(PG8_SB(1, 0), b3, voffB); PG8_STAGE(PG8_SB(1, 1), b3 + hstepB, voffB); PG8_STAGE(PG8_SA(1, 0), a3, voffA);
            PG8_WAIT_V(8); PG8_WAIT_L(0); PG8_BAR; if (full) { PG8_MMA(1, 0, At, B0); PG8_MMA(1, 1, At, B1); } PG8_BAR; PG8_SCHED;
            } else {
            PG8_LDB(B0, 0, 0); PG8_SCHED; PG8_LDA(At, 0, 0); PG8_STAGE(PG8_SA(1, 1), a1 + hstepA, voffA);
            PG8_WAIT_L(8); PG8_BAR; PG8_WAIT_L(0); PG8_MMA(0, 0, At, B0); PG8_BAR; PG8_SCHED;
            PG8_LDB(B1, 0, 1); PG8_STAGE(PG8_SB(0, 0), b2, voffB);
            PG8_BAR; PG8_WAIT_L(0); PG8_MMA(0, 1, At, B1); PG8_BAR;
            if (full) PG8_LDA(At, 0, 1); PG8_STAGE(PG8_SA(0, 0), a2, voffA);
            PG8_BAR; PG8_WAIT_L(0); if (full) PG8_MMA(1, 0, At, B0); PG8_BAR; PG8_SCHED;
            PG8_STAGE(PG8_SB(0, 1), b2 + hstepB, voffB);
            PG8_WAIT_V(6); PG8_BAR; if (full) PG8_MMA(1, 1, At, B1); PG8_BAR;
            PG8_LDB(B0, 1, 0); PG8_SCHED; PG8_LDA(At, 1, 0); PG8_STAGE(PG8_SA(0, 1), a2 + hstepA, voffA);
            PG8_WAIT_L(8); PG8_BAR; PG8_WAIT_L(0); PG8_MMA(0, 0, At, B0); PG8_BAR; PG8_SCHED;
            PG8_LDB(B1, 1, 1); PG8_STAGE(PG8_SB(1, 0), b3, voffB);
            PG8_BAR; PG8_WAIT_L(0); PG8_MMA(0, 1, At, B1); PG8_BAR;
            if (full) PG8_LDA(At, 1, 1); PG8_STAGE(PG8_SA(1, 0), a3, voffA);
            PG8_BAR; PG8_WAIT_L(0); if (full) PG8_MMA(1, 0, At, B0); PG8_BAR; PG8_SCHED;
            PG8_STAGE(PG8_SB(1, 1), b3 + hstepB, voffB);
            PG8_WAIT_V(6); PG8_BAR; if (full) PG8_MMA(1, 1, At, B1); PG8_BAR;
            }
        }
        if constexpr (ALIGN_EPI) { if (wr == 0) PG8_BAR; }
        E(acc, cur, wr, wc, fr, fq, pre);
        if (!has_next) break;
        E.prefetch(nxt, wr, lane, pre);
#pragma unroll
        for (int a = 0; a < 2; ++a)
#pragma unroll
            for (int b = 0; b < 2; ++b)
#pragma unroll
                for (int m = 0; m < 4; ++m)
#pragma unroll
                    for (int n = 0; n < 2; ++n) acc[a][b][m][n] = (f32x4){0.f, 0.f, 0.f, 0.f};
        cur = nxt; cA = nA; cB = nB; ++ui;
        if constexpr (ALIGN_EPI) { if (wr == 1) PG8_BAR; }
    }
    PG8_WAIT_V(0);
    if constexpr (!ALIGN_EPI) { if (wr == 0) PG8_BAR; }
    PG8_BAR;
#undef PG8_SA
#undef PG8_SB
#undef PG8_STAGE
#undef PG8_LDA
#undef PG8_LDB
#undef PG8_MMA
#undef PG8_WAIT_V
#undef PG8_WAIT_L
#undef PG8_BAR
#undef PG8_SCHED
}
}

#define XB_TMO      128
#define XB_XCNT(j)  (256  + 64 * (j))
#define XB_XSUB(j)  (1280 + 64 * (j))
#define XB_XGEN(j)  (2304 + 64 * (j))
#define XB_TOP      3328
#define XB_TOPGEN   3392
#define XCD_BAR_WORDS 3456
#define XB_SPIN_CAP (1u << 18)
__device__ __forceinline__ unsigned xb_ld(unsigned* p)              { return __hip_atomic_load(p, __ATOMIC_RELAXED, __HIP_MEMORY_SCOPE_AGENT); }
__device__ __forceinline__ unsigned xb_add(unsigned* p, unsigned v) { return __hip_atomic_fetch_add(p, v, __ATOMIC_RELAXED, __HIP_MEMORY_SCOPE_AGENT); }
__device__ __forceinline__ unsigned xb_xcc_id() { return (unsigned)__builtin_amdgcn_s_getreg((3 << 11) | 20) & 0xFu; }
#define XB_SPIN(cond, bar) do { unsigned _sp = 0; while (cond) { __builtin_amdgcn_s_sleep(1); \
    if ((++_sp & 255u) == 0u) { if (xb_ld(&(bar)[XB_TMO])) break; if (_sp > XB_SPIN_CAP) { atomicAdd(&(bar)[XB_TMO], 1u); break; } } } } while (0)
struct XcdBarrier { unsigned* bar; unsigned x; volatile LAS unsigned* st; };
__device__ __forceinline__ XcdBarrier xcd_barrier_post(unsigned* bar, volatile LAS unsigned* st) {
    XcdBarrier b; b.bar = bar; b.x = xb_xcc_id(); b.st = st;
    if (threadIdx.x == 0) (void)xb_add(&bar[XB_XCNT(b.x)], 1u);
    return b;
}
__device__ __forceinline__ void xcd_barrier_complete(unsigned* bar, unsigned x, unsigned& nloc, unsigned& nx) {
    const unsigned G = gridDim.x * gridDim.y * gridDim.z;
    unsigned sum, cnt, mine, sp = 0u;
    for (;;) {
        sum = 0u; cnt = 0u; mine = 0u;
#pragma unroll
        for (unsigned j = 0; j < 16; ++j) { const unsigned c = xb_ld(&bar[XB_XCNT(j)]); sum += c; cnt += (c > 0u) ? 1u : 0u; mine = (j == x) ? c : mine; }
        if (sum == G) break;
        __builtin_amdgcn_s_sleep(1);
        if ((++sp & 255u) == 0u) { if (xb_ld(&bar[XB_TMO])) break; if (sp > XB_SPIN_CAP) { atomicAdd(&bar[XB_TMO], 1u); break; } }
    }
    nloc = mine > 0u ? mine : 1u; nx = cnt > 0u ? cnt : 1u;
}
__device__ __forceinline__ void xcd_barrier(const XcdBarrier& b) {
    asm volatile("s_waitcnt vmcnt(0)" ::: "memory");
    __syncthreads();
    if (threadIdx.x == 0) {
        unsigned* bar = b.bar;
        __builtin_amdgcn_s_waitcnt(0);
        unsigned nloc = b.st[0], nx = b.st[1];
        if (nloc == 0u) { xcd_barrier_complete(bar, b.x, nloc, nx); b.st[0] = nloc; b.st[1] = nx; }
        const unsigned old = xb_add(&bar[XB_XSUB(b.x)], 1u);
        const unsigned gen = old / nloc;
        if (old + 1u == (gen + 1u) * nloc) {
            __builtin_amdgcn_fence(__ATOMIC_RELEASE, "agent");
            asm volatile("s_waitcnt vmcnt(0)" ::: "memory");
            const unsigned og = xb_add(&bar[XB_TOP], 1u);
            const unsigned tg = og / nx;
            if (og + 1u == (tg + 1u) * nx) xb_add(&bar[XB_TOPGEN], 1u);
            else XB_SPIN(xb_ld(&bar[XB_TOPGEN]) == tg, bar);
            __builtin_amdgcn_fence(__ATOMIC_ACQUIRE, "agent");
            xb_add(&bar[XB_XGEN(b.x)], 1u);
            asm volatile("s_waitcnt vmcnt(0)" ::: "memory");
        } else {
            XB_SPIN(xb_ld(&bar[XB_XGEN(b.x)]) == gen, bar);
            __builtin_amdgcn_fence(__ATOMIC_ACQUIRE, "agent");
            asm volatile("s_waitcnt vmcnt(0)" ::: "memory");
        }
    }
    __syncthreads();
}

constexpr int CW_GMASK = 512, CW_GCNT = 1024, CW_GTMO = 2048, CW_PCNT = 8192;
__device__ __forceinline__ void group_barrier(unsigned* ctl, int grp, unsigned target) {
    asm volatile("s_waitcnt vmcnt(0)" ::: "memory");
    __syncthreads();
    if (threadIdx.x == 0) {
        __builtin_amdgcn_s_waitcnt(0);
        unsigned* cnt = ctl + CW_GCNT + 64 * grp;
        (void)xb_add(cnt, 1u);
        unsigned sp = 0;
        while (xb_ld(cnt) < target) { __builtin_amdgcn_s_sleep(1);
            if ((++sp & 255u) == 0u) { if (xb_ld(ctl + CW_GTMO)) break; if (sp > XB_SPIN_CAP) { atomicAdd(ctl + CW_GTMO, 1u); break; } } }
        __builtin_amdgcn_fence(__ATOMIC_ACQUIRE, "agent");
        asm volatile("s_waitcnt vmcnt(0)" ::: "memory");
    }
    __syncthreads();
}

struct Args { const float* in[17]; float* out; unsigned char* ws; int ph_lo, ph_hi; };

__device__ __forceinline__ void p0_item(const float* src, int lds_, bf16_t* dst, int Kdst, const float* gk, const float* sn, float cst, LAS float* scr, int lane) {
    f32x4 v[16];
#pragma unroll
    for (int i = 0; i < 16; ++i) v[i] = __builtin_nontemporal_load((const f32x4*)(src + (size_t)(4 * i + (lane >> 4)) * lds_ + 4 * (lane & 15)));
#pragma unroll
    for (int i = 0; i < 16; ++i) { LAS float* p = scr + (4 * i + (lane >> 4)) * 65 + 4 * (lane & 15); p[0] = v[i][0]; p[1] = v[i][1]; p[2] = v[i][2]; p[3] = v[i][3]; }
    const int c = lane & 7, r = lane >> 3;
    float gs[8];
#pragma unroll
    for (int i = 0; i < 8; ++i) gs[i] = (gk ? gk[8 * c + i] : 1.0f) * cst;
    LDS_WAIT(); asm volatile("" ::: "memory");
#pragma unroll
    for (int j = 0; j < 8; ++j) {
        const int n = r + 8 * j; const float s = sn ? sn[n] : 1.0f; const LAS float* p = scr + (8 * c) * 65 + n;
        float x[8];
#pragma unroll
        for (int i = 0; i < 8; ++i) x[i] = p[i * 65] * gs[i] * s;
        u32x4 o; o.x = cvt_pk_bf16(x[0], x[1]); o.y = cvt_pk_bf16(x[2], x[3]); o.z = cvt_pk_bf16(x[4], x[5]); o.w = cvt_pk_bf16(x[6], x[7]);
        __builtin_nontemporal_store(o, (u32x4*)(dst + (size_t)n * Kdst + 8 * c));
    }
    LDS_WAIT(); asm volatile("" ::: "memory");
}
constexpr int I_FFN1 = 16 * 44, I_FFN = 3 * I_FFN1, I_FFN_ALL = 8 * I_FFN;
constexpr int I_CIN = 16 * 32, I_COUT = 16 * 16, I_CONV = I_CIN + I_COUT, I_CONV_ALL = 2 * I_CONV;
constexpr int I_POOL = 4 * 16, I_POOL_ALL = 2 * I_POOL;
constexpr int I_ALL = I_FFN_ALL + I_CONV_ALL + I_POOL_ALL;
__device__ __forceinline__ void p0_prologue(const Args& a, LAS unsigned char* lds, int vcu, int G, int wave, int lane) {
    LAS float* scr = (LAS float*)(lds + wave * (64 * 65 * 4));
    const int gw = vcu * NWAVES + wave, NGW = G * NWAVES;
    unsigned char* ws = a.ws;
    for (int it0 = gw; it0 < I_ALL; it0 += NGW) {
        int it = it0;
        if (it < I_FFN_ALL) {
            const int f = it / I_FFN, r = it % I_FFN, ty = r / I_FFN1, q = r % I_FFN1;
            if (ty < 2) {
                const int kb = q / 44, nb = q % 44, k0 = 64 * kb, n0 = 64 * nb;
                const float* src = (ty == 0 ? a.in[2] : a.in[3]) + (size_t)f * D * FF + (size_t)k0 * FF + n0;
                const int R0 = 256 * (n0 / 128) + 128 * ty + (n0 % 128);
                bf16_t* dst = (bf16_t*)(ws + WS_WGU) + (size_t)f * 2 * FF * D + (size_t)R0 * D + k0;
                p0_item(src, FF, dst, D, a.in[1] + f * D + k0, nullptr, 1.0f, scr, lane);
            } else {
                const int kb = q / 16, nb = q % 16, k0 = 64 * kb, n0 = 64 * nb;
                const float* src = a.in[4] + (size_t)f * FF * D + (size_t)k0 * D + n0;
                bf16_t* dst = (bf16_t*)(ws + WS_WD) + (size_t)f * D * FF + (size_t)n0 * FF + k0;
                p0_item(src, D, dst, FF, nullptr, nullptr, 0.5f, scr, lane);
            }
            continue;
        }
        it -= I_FFN_ALL;
        if (it < I_CONV_ALL) {
            const int j = it / I_CONV, r = it % I_CONV;
            if (r < I_CIN) {
                const int kb = r / 32, nb = r % 32, k0 = 64 * kb, n0 = 64 * nb, which = n0 / D, cc = n0 % D;
                const float* src = a.in[6] + (size_t)j * D * 2 * D + (size_t)k0 * 2 * D + n0;
                const int R0 = 256 * (cc / 128) + 128 * which + (cc % 128);
                bf16_t* dst = (bf16_t*)(ws + WS_WIN) + (size_t)j * 2 * D * D + (size_t)R0 * D + k0;
                p0_item(src, 2 * D, dst, D, a.in[5] + (2 * j) * D + k0, nullptr, 1.0f, scr, lane);
            } else {
                const int rr = r - I_CIN, kb = rr / 16, nb = rr % 16, k0 = 64 * kb, n0 = 64 * nb;
                const float* src = a.in[12] + (size_t)j * D * D + (size_t)k0 * D + n0;
                bf16_t* dst = (bf16_t*)(ws + WS_WOUT) + (size_t)j * D * D + (size_t)n0 * D + k0;
                p0_item(src, D, dst, D, nullptr, nullptr, 1.0f, scr, lane);
            }
            continue;
        }
        it -= I_CONV_ALL;
        {
            const int j = it / I_POOL, r = it % I_POOL, gp = r / 16, rr = r % 16, kb = rr / 4, nb = rr % 4, k0 = 64 * kb, n0 = 64 * nb;
            const float* src = a.in[14] + (size_t)(j * 4 + gp) * 256 * 256 + (size_t)k0 * 256 + n0;
            bf16_t* dst = (bf16_t*)(ws + WS_WP) + (size_t)j * D * 256 + (size_t)(gp * 256 + n0) * 256 + k0;
            p0_item(src, 256, dst, 256, a.in[5] + (2 * j + 1) * D + gp * 256 + k0, a.in[15] + j * D + gp * 256 + n0, 1.0f, scr, lane);
        }
    }
    const float* x = a.in[0]; bf16_t* XB = (bf16_t*)(ws + WS_XB); float* ssq0 = (float*)(ws + WS_SSQ);
    for (int mi = 0; mi < 8; ++mi) {
        const int m = 64 * vcu + 8 * wave + mi;
        const f32x4* xr = (const f32x4*)(x + (size_t)m * D) + lane;
        f32x4 v[4]; float s = 0.f;
#pragma unroll
        for (int j = 0; j < 4; ++j) { v[j] = __builtin_nontemporal_load(xr + 64 * j); s += (v[j][0] * v[j][0] + v[j][1] * v[j][1]) + (v[j][2] * v[j][2] + v[j][3] * v[j][3]); }
        s = wave_sum(s);
        u32x2* o8 = (u32x2*)(XB + (size_t)m * D) + lane;
#pragma unroll
        for (int j = 0; j < 4; ++j) { u32x2 w; w.x = cvt_pk_bf16(v[j][0], v[j][1]); w.y = cvt_pk_bf16(v[j][2], v[j][3]); o8[64 * j] = w; }
        if (lane == 0) ssq0[m] = s;
    }
}

__device__ __forceinline__ void final_phase(float* xo, const float* ssq, const float* gain, int vcu, int G, int wave, int lane) {
    f32x4 gv[4];
#pragma unroll
    for (int j = 0; j < 4; ++j) gv[j] = ((const f32x4*)gain)[lane + 64 * j];
    for (int mi = 0; mi < 8; ++mi) {
        const int m = 64 * vcu + 8 * wave + mi;
        f32x4* xr = (f32x4*)(xo + (size_t)m * D) + lane;
        const float r = __builtin_amdgcn_rsqf(__hip_atomic_load(ssq + m, __ATOMIC_RELAXED, __HIP_MEMORY_SCOPE_AGENT) * (1.0f / D) + EPS);
        f32x4 v[4];
#pragma unroll
        for (int j = 0; j < 4; ++j) v[j] = __builtin_nontemporal_load(xr + 64 * j);
#pragma unroll
        for (int j = 0; j < 4; ++j) __builtin_nontemporal_store(v[j] * r * gv[j], xr + 64 * j);
    }
}

template <int W>
__device__ __forceinline__ void pool_chunk(const float* x, const float* ssq, bf16_t* P, int m0, int t0, int tid, int lane) {
    const int c = 2 * tid;
    f32x2 buf[W];
#pragma unroll
    for (int i = 0; i < W; ++i) buf[i] = (f32x2){0.f, 0.f};
    f32x2 S = (f32x2){0.f, 0.f};
    if (t0 > 0) {
        const float sq = ssq[m0 - 16 + (lane & 15)];
        const float rl = __builtin_amdgcn_rsqf(sq * (1.0f / D) + EPS);
#pragma unroll
        for (int i = 1; i < W; ++i) {
            const float r = __shfl(rl, 16 - W + i);
            const f32x2 v = *(const f32x2*)(x + (size_t)(m0 - W + i) * D + c) * r;
            buf[i] = v; S += v;
        }
    }
#pragma unroll 1
    for (int rb = 0; rb < 64; rb += 16) {
        const float sq = ssq[m0 + rb + (lane & 15)];
        const float rl = __builtin_amdgcn_rsqf(sq * (1.0f / D) + EPS);
        f32x2 v[16];
#pragma unroll
        for (int i = 0; i < 16; ++i) v[i] = *(const f32x2*)(x + (size_t)(m0 + rb + i) * D + c);
#pragma unroll
        for (int i = 0; i < 16; ++i) {
            const float r = __shfl(rl, i);
            const f32x2 hv = v[i] * r;
            S += hv - buf[i % W]; buf[i % W] = hv;
            const int t = t0 + rb + i; const float inv = 1.0f / (float)((t + 1) < W ? (t + 1) : W);
            const f32x2 p = S * inv - hv;
            *(unsigned*)(P + (size_t)(m0 + rb + i) * D + c) = cvt_pk_bf16(p[0], p[1]);
        }
    }
}
__device__ __forceinline__ void pool_phase(const float* x, const float* ssq, bf16_t* P, int vcu, int G, int tid, int wave, int lane) {
    {
        const int ch = vcu;
        const int m0 = 64 * ch, t0 = m0 % SEQ; const int gsel = wave >> 1;
        if (gsel == 0) pool_chunk<2>(x, ssq, P, m0, t0, tid, lane);
        else if (gsel == 1) pool_chunk<4>(x, ssq, P, m0, t0, tid, lane);
        else if (gsel == 2) pool_chunk<8>(x, ssq, P, m0, t0, tid, lane);
        else pool_chunk<16>(x, ssq, P, m0, t0, tid, lane);
    }
}

constexpr int CV_ROWS = 32, CV_HALO = CONVW - 1, CV_LROWS = CV_ROWS + CV_HALO  , CV_RED_OFF = CV_LROWS * D * 2  ;
__device__ __forceinline__ void conv_phase(const bf16_t* V, bf16_t* C, const float* dw, const float* dwb, const float* lng, const float* lnb, LAS unsigned char* lds, int vcu, int G, int tid, int wave, int lane) {
    const int c = 128 * wave + 2 * lane;
    f32x2 w[CONVW];
#pragma unroll
    for (int k = 0; k < CONVW; ++k) w[k] = *(const f32x2*)(dw + k * D + c);
    const f32x2 bconv = *(const f32x2*)(dwb + c), gg = *(const f32x2*)(lng + c), bb = *(const f32x2*)(lnb + c);
    LAS f32x2* red = (LAS f32x2*)(lds + CV_RED_OFF);
    for (int ck = 0; ck < 2; ++ck) {
        const int ch = 2 * vcu + ck;
        const int m0 = CV_ROWS * ch, t0 = m0 % SEQ;
        {
            u32x4 st[16];
#pragma unroll
            for (int i = 0; i < 16; ++i) { const int p = tid + 512 * i, j = p >> 7, off = (p & 127) * 8;
                st[i] = (u32x4){0u, 0u, 0u, 0u};
                if (p < CV_LROWS * 128 && (t0 + j - CV_HALO) >= 0) st[i] = *(const u32x4*)(V + (size_t)(m0 + j - CV_HALO) * D + off); }
#pragma unroll
            for (int i = 0; i < 16; ++i) { const int p = tid + 512 * i; if (p < CV_LROWS * 128) *(LAS u32x4*)(lds + (size_t)p * 16) = st[i]; }
        }
        LDS_WAIT(); __syncthreads();
#pragma unroll 1
        for (int hf = 0; hf < 2; ++hf) {
            f32x2 y[16];
            const LAS unsigned char* lp = lds + c * 2 + hf * 16 * (D * 2);
#pragma unroll
            for (int q = 0; q < 2; ++q) {
                f32x2 ac[8];
#pragma unroll
                for (int i = 0; i < 8; ++i) ac[i] = bconv;
#pragma unroll
                for (int jj = 0; jj < 38; ++jj) {
                    const unsigned u = *(const LAS unsigned*)(lp + (8 * q + jj) * (D * 2));
                    const f32x2 v = (f32x2){bf_lo(u), bf_hi(u)};
#pragma unroll
                    for (int i = 0; i < 8; ++i) { const int k = jj - i; if (k >= 0 && k <= 30) ac[i] += w[k] * v; }
                }
#pragma unroll
                for (int i = 0; i < 8; ++i) y[8 * q + i] = ac[i];
            }
            {
                const bool b5 = (lane & 32) != 0, b4 = (lane & 16) != 0, b3 = (lane & 8) != 0, b2 = (lane & 4) != 0, b1 = (lane & 2) != 0;
                float x16[16], x8[8], x4[4], x2[2], x1;
#pragma unroll
                for (int i = 0; i < 16; ++i) { const float s1 = y[i][0] + y[i][1], s2 = y[i][0] * y[i][0] + y[i][1] * y[i][1];
                    const float snd = b5 ? s1 : s2, kp = b5 ? s2 : s1; x16[i] = kp + __shfl_xor(snd, 32); }
#pragma unroll
                for (int i = 0; i < 8; ++i) { const float snd = b4 ? x16[i] : x16[8 + i], kp = b4 ? x16[8 + i] : x16[i]; x8[i] = kp + __shfl_xor(snd, 16); }
#pragma unroll
                for (int i = 0; i < 4; ++i) { const float snd = b3 ? x8[i] : x8[4 + i], kp = b3 ? x8[4 + i] : x8[i]; x4[i] = kp + __shfl_xor(snd, 8); }
#pragma unroll
                for (int i = 0; i < 2; ++i) { const float snd = b2 ? x4[i] : x4[2 + i], kp = b2 ? x4[2 + i] : x4[i]; x2[i] = kp + __shfl_xor(snd, 4); }
                { const float snd = b1 ? x2[0] : x2[1], kp = b1 ? x2[1] : x2[0]; x1 = kp + __shfl_xor(snd, 2); }
                x1 += __shfl_xor(x1, 1);
                if ((lane & 1) == 0) ((LAS float*)red)[(((hf * 16 + ((lane >> 1) & 15)) * 8 + wave) << 1) + (b5 ? 1 : 0)] = x1;
            }
            LDS_WAIT(); __syncthreads();
            float mean_l = 0.f, rstd_l = 0.f;
            if (lane < 16) {
                float s1 = 0.f, s2 = 0.f;
#pragma unroll
                for (int k = 0; k < 8; ++k) { const f32x2 p = red[(hf * 16 + lane) * 8 + k]; s1 += p[0]; s2 += p[1]; }
                mean_l = s1 * (1.0f / D); const float var = s2 * (1.0f / D) - mean_l * mean_l;
                rstd_l = __builtin_amdgcn_rsqf((var > 0.f ? var : 0.f) + EPS);
            }
#pragma unroll
            for (int o = 0; o < 16; ++o) {
                const float mean = __shfl(mean_l, o), rstd = __shfl(rstd_l, o);
                const f32x2 z = (y[o] - mean) * rstd * gg + bb;
                const float o0 = z[0] * fast_sigmoid(z[0]), o1 = z[1] * fast_sigmoid(z[1]);
                *(unsigned*)(C + (size_t)(m0 + hf * 16 + o) * D + c) = cvt_pk_bf16(o0, o1);
            }
        }
        __syncthreads();
    }
    __syncthreads();
}

__global__ void __launch_bounds__(NWAVES * 64, 2) trunk_fwd(Args args) {
    extern __shared__ __attribute__((aligned(16))) unsigned char lds_raw[];
    LAS unsigned char* lds = (LAS unsigned char*)lds_raw;
    const int tid0 = threadIdx.x;
    const int G = gridDim.x; const int bx = blockIdx.x; const int vcu = (G % 8 == 0) ? (bx % 8) * (G / 8) + bx / 8 : bx;
    unsigned char* ws = args.ws;
    volatile LAS unsigned* MISC = (volatile LAS unsigned*)(lds + LDSCTL_OFF);
    for (int u = tid0; u < (LDS_BYTES - LDSCTL_OFF) / 4; u += NWAVES * 64) MISC[u] = 0u;
    __syncthreads();
#if !MK_PER_PHASE
    XcdBarrier bar = xcd_barrier_post((unsigned*)(ws + WS_CTL) + CW_BAR, MISC + 8);
    if (tid0 == 0) atomicOr((unsigned*)(ws + WS_CTL) + CW_GMASK + 64 * (bx & 7), 1u << xb_xcc_id());
    unsigned fast = 0u, gb_epoch = 0u;
#endif
    bf16_t* const XB = (bf16_t*)(ws + WS_XB); bf16_t* const HB = (bf16_t*)(ws + WS_H);
    bf16_t* const VB = (bf16_t*)(ws + WS_V); bf16_t* const CB = (bf16_t*)(ws + WS_C); bf16_t* const PB = (bf16_t*)(ws + WS_P);
    float* const SSQ = (float*)(ws + WS_SSQ);
    float* const xo = args.out;

    const int lo = args.ph_lo, hi = args.ph_hi;
#pragma unroll 1
    for (int ph = lo; ph < hi; ++ph) {
        int ty, L = 0, s = 0;
        if (ph == 0) ty = 0;
        else if (ph == 27) ty = 8;
        else {
            const int q = ph - 1; int r;
            if (q < 7) { L = 0; r = q; } else if (q < 13) { L = 1; r = q - 7; } else if (q < 20) { L = 2; r = q - 13; } else { L = 3; r = q - 20; }
            if ((L & 1) == 0) { const int tab = r; ty = (tab == 0 || tab == 5) ? 1 : (tab == 1 || tab == 6) ? 2 : (tab == 2) ? 3 : (tab == 3) ? 4 : 5; s = (tab >= 5) ? 1 : 0; }
            else { const int tab = r; ty = (tab == 0 || tab == 4) ? 1 : (tab == 1 || tab == 5) ? 2 : (tab == 2) ? 6 : 7; s = (tab >= 4) ? 1 : 0; }
        }
        const int f = 2 * L + s, j = L >> 1;
#if PROBE_MASK
        const int nrep = ((PROBE_MASK >> ty) & 1) ? 2 : 1;
#pragma unroll 1
        for (int rep = 0; rep < nrep; ++rep) {
        const bool dummy = (rep == 1);
#else
        {
        const bool dummy = false;
#endif
        int tid = tid0; asm volatile("" : "+v"(tid));
        const int lane = tid & 63, wave = __builtin_amdgcn_readfirstlane(tid >> 6);
        float* const o_f32 = dummy ? (float*)(ws + WS_END) : xo; bf16_t* const o_xb = dummy ? (bf16_t*)(ws + WS_END) : XB;
        if (ty == 0) {
            p0_prologue(args, lds, vcu, G, wave, lane);
        } else if (ty == 1) {
            pg8::Gemm g{XB, (const bf16_t*)(ws + WS_WGU) + (size_t)f * 2 * FF * D, D, D, D, 0};
            pg8::StaticOrder S; S.init(2 * FF, bx);
            pg8::EpiSwiGLU E{HB, FF, SSQ + (size_t)(3 * L + 2 * s) * M, dummy};
            pg8::gemm_phase<pg8::EpiSwiGLU, true>(lds, g, S, E, tid);
        } else if (ty == 2) {
            pg8::Gemm g{HB, (const bf16_t*)(ws + WS_WD) + (size_t)f * D * FF, FF, FF, FF, 0};
            pg8::StaticOrder S; S.init(D, bx);
            if (L == DEPTH - 1 && s == 1 && !dummy) {
                pg8::StaticOrder S2; S2.init(D, bx);
                pg8::EpiFinal EF{xo, xo, args.in[16], SSQ + (size_t)12 * M, (unsigned*)(ws + WS_CTL) + CW_PCNT, (unsigned*)(ws + WS_CTL) + CW_GTMO};
                pg8::gemm_phase<pg8::EpiFinal, true>(lds, g, S2, EF, tid);
            } else {
            const bool xb_dead = ((L & 1) == 1 && s == 0) || (L == DEPTH - 1 && s == 1);
            pg8::EpiResid E{(f == 0) ? args.in[0] : xo, o_f32, xb_dead ? (bf16_t*)nullptr : o_xb, nullptr, SSQ + (size_t)(dummy ? 14 : 3 * L + 2 * s + 1) * M};
            pg8::gemm_phase<pg8::EpiResid, true>(lds, g, S, E, tid);
            }
        } else if (ty == 3) {
            pg8::Gemm g{XB, (const bf16_t*)(ws + WS_WIN) + (size_t)j * 2 * D * D, D, D, D, 0};
            pg8::StaticOrder S; S.init(2 * D, bx);
            pg8::EpiGLU E{VB, SSQ + (size_t)(3 * L + 1) * M, args.in[7] + (size_t)j * 2 * D};
            pg8::gemm_phase<pg8::EpiGLU, true>(lds, g, S, E, tid);
        } else if (ty == 4) {
            conv_phase(VB, CB, args.in[8] + (size_t)j * CONVW * D, args.in[9] + j * D, args.in[10] + j * D, args.in[11] + j * D, lds, vcu, G, tid, wave, lane);
        } else if (ty == 5) {
            pg8::Gemm g{CB, (const bf16_t*)(ws + WS_WOUT) + (size_t)j * D * D, D, D, D, 0};
            pg8::StaticOrder S; S.init(D, bx);
            pg8::EpiResid E{xo, o_f32, o_xb, args.in[13] + j * D, SSQ + (size_t)(dummy ? 14 : 3 * L + 2) * M};
            pg8::gemm_phase<pg8::EpiResid, true>(lds, g, S, E, tid);
        } else if (ty == 6) {
            pool_phase(xo, SSQ + (size_t)(3 * L + 1) * M, PB, vcu, G, tid, wave, lane);
        } else if (ty == 7) {
            pg8::Gemm g{PB, (const bf16_t*)(ws + WS_WP) + (size_t)j * D * 256, D, 256, 256, 512};
            pg8::StaticOrder S; S.init(D, bx);
            pg8::EpiResid E{xo, o_f32, o_xb, nullptr, SSQ + (size_t)(dummy ? 14 : 3 * L + 2) * M};
            pg8::gemm_phase<pg8::EpiResid, true>(lds, g, S, E, tid);
        } else {
            final_phase(xo, SSQ + (size_t)12 * M, args.in[16], vcu, G, wave, lane);
        }
        }
#if !MK_PER_PHASE
        if (ph + 1 < hi) {
            if (ph == 0) {
                if (lo < 0) cg::this_grid().sync();
                xcd_barrier(bar);
                if (tid0 == 0) { unsigned ok = (G == 256) ? 1u : 0u;
                    unsigned all = 0u;
                    for (int gi = 0; gi < 8; ++gi) { const unsigned mk = xb_ld((unsigned*)(ws + WS_CTL) + CW_GMASK + 64 * gi); if (__builtin_popcount(mk) != 1) ok = 0u; all |= mk; }
                    if (__builtin_popcount(all) != 8) ok = 0u;
                    MISC[16] = ok; }
                __syncthreads();
                fast = (unsigned)__builtin_amdgcn_readfirstlane((int)MISC[16]);
            }
            else if (fast) { ++gb_epoch; group_barrier((unsigned*)(ws + WS_CTL), bx & 7, gb_epoch * 32u); }
            else xcd_barrier(bar);
        }
#endif
    }
}

extern "C" void kernel_launch(void* const* d_in, const int* in_sizes, int n_in, void* d_out, int out_size, void* d_ws, size_t ws_size, hipStream_t stream) {
    static int grid = 0;
    if (grid == 0) {
        if (n_in != 17 || in_sizes[0] != M * D || out_size != M * D || ws_size < WS_END) { fprintf(stderr, "kernel_launch: unexpected shapes (n_in %d, in0 %d, out %d, ws %zu); nothing launched\n", n_in, n_in > 0 ? in_sizes[0] : -1, out_size, ws_size); grid = -1; return; }
        int dev = 0, cus = 0, per_cu = 0;
        if (hipGetDevice(&dev) != hipSuccess || hipDeviceGetAttribute(&cus, hipDeviceAttributeMultiprocessorCount, dev) != hipSuccess) { grid = -1; return; }
        if (hipFuncSetAttribute((const void*)trunk_fwd, hipFuncAttributeMaxDynamicSharedMemorySize, LDS_BYTES) != hipSuccess) { fprintf(stderr, "kernel_launch: hipFuncSetAttribute failed\n"); grid = -1; return; }
        if (hipOccupancyMaxActiveBlocksPerMultiprocessor(&per_cu, (const void*)trunk_fwd, NWAVES * 64, LDS_BYTES) != hipSuccess || per_cu < 1) { fprintf(stderr, "kernel_launch: occupancy query says %d blocks per CU\n", per_cu); per_cu = 1; }
        (void)hipGetLastError();
        grid = cus * (per_cu > 1 ? 1 : per_cu);
        if (grid != 256) { fprintf(stderr, "kernel_launch: this kernel's unit order is built for a 256-CU device (got %d); nothing launched\n", grid); grid = -1; return; }
    }
    if (grid < 0) return;
    if (hipMemsetAsync((char*)d_ws + WS_CTL, 0, CTL_ZERO_BYTES, stream) != hipSuccess) { fprintf(stderr, "kernel_launch: hipMemsetAsync failed\n"); return; }
    Args a{};
    for (int i = 0; i < 17; ++i) a.in[i] = (const float*)d_in[i];
    a.out = (float*)d_out; a.ws = (unsigned char*)d_ws;
#if MK_PER_PHASE
    for (int ph = 0; ph < 27; ++ph) { a.ph_lo = ph; a.ph_hi = ph + 1; hipLaunchKernelGGL(trunk_fwd, dim3(grid), dim3(NWAVES * 64), LDS_BYTES, stream, a); }
#else
    a.ph_lo = 0; a.ph_hi = 27;
    void* kargs[] = {&a};
    hipError_t e = hipLaunchCooperativeKernel((const void*)trunk_fwd, dim3(grid), dim3(NWAVES * 64), kargs, LDS_BYTES, stream);
    if (e != hipSuccess) fprintf(stderr, "kernel_launch: cooperative launch failed: %s (grid %d)\n", hipGetErrorString(e), grid);
#endif
}
```

```cpp
#include <hip/hip_runtime.h>
#include <hip/hip_cooperative_groups.h>
#include <cstdio>
#include <cstdint>
namespace cg = cooperative_groups;

#ifndef PROBE_MASK
#define PROBE_MASK 0
#endif
#ifndef MK_PER_PHASE
#define MK_PER_PHASE 0
#endif

#define GAS __attribute__((address_space(1)))
#define LAS __attribute__((address_space(3)))
typedef unsigned short bf16_t;
typedef short bf16x8 __attribute__((ext_vector_type(8)));
typedef float f32x4 __attribute__((ext_vector_type(4)));
typedef float f32x2 __attribute__((ext_vector_type(2)));
typedef unsigned u32x4 __attribute__((ext_vector_type(4)));
typedef unsigned u32x2 __attribute__((ext_vector_type(2)));

constexpr int D = 1024, FF = 2816, BATCH = 8, SEQ = 2048, M = BATCH * SEQ, DEPTH = 4, CONVW = 31;
constexpr float EPS = 1e-6f;
constexpr int NWAVES = 8;

constexpr size_t MiB = 1u << 20;
constexpr size_t WS_CTL = 0, CTL_ZERO_BYTES = 2 * MiB;
constexpr size_t WS_SSQ = 1 * MiB;
constexpr size_t WS_WGU = 2 * MiB;
constexpr size_t WS_WD = 90 * MiB;
constexpr size_t WS_WIN = 134 * MiB;
constexpr size_t WS_WOUT = 142 * MiB;
constexpr size_t WS_WP = 146 * MiB;
constexpr size_t WS_XB = 148 * MiB;
constexpr size_t WS_H = 180 * MiB;
constexpr size_t WS_V = 268 * MiB, WS_P = WS_V, WS_C = 300 * MiB;
constexpr size_t WS_END = 332 * MiB;
constexpr int CW_BAR = 4096;

constexpr int RING_BYTES = 131072;
constexpr int PRO_SCR_BYTES = 8 * 64 * 65 * 4;
constexpr int LDSCTL_OFF = 133120;
constexpr int LDS_BYTES = 134144;
static_assert(PRO_SCR_BYTES <= LDSCTL_OFF && LDSCTL_OFF % 16 == 0, "LDS map");

#define LDS_WAIT() asm volatile("s_waitcnt lgkmcnt(0)" ::: "memory")
#define VM_WAIT() asm volatile("s_waitcnt vmcnt(0)" ::: "memory")
typedef __bf16 bf16x2_t __attribute__((ext_vector_type(2)));
__device__ __forceinline__ unsigned cvt_pk_bf16(float lo, float hi) { const bf16x2_t b = __builtin_convertvector((f32x2){lo, hi}, bf16x2_t); return __builtin_bit_cast(unsigned, b); }
__device__ __forceinline__ float bf_lo(unsigned w) { return __builtin_bit_cast(float, w << 16); }
__device__ __forceinline__ float bf_hi(unsigned w) { return __builtin_bit_cast(float, w & 0xffff0000u); }
__device__ __forceinline__ float fast_sigmoid(float x) { return __builtin_amdgcn_rcpf(1.0f + __builtin_amdgcn_exp2f(-1.4426950408889634f * x)); }
__device__ __forceinline__ float wave_sum(float v) {
#pragma unroll
    for (int o = 1; o < 64; o <<= 1) v += __shfl_xor(v, o);
    return v;
}

namespace pg8 {
constexpr int BM = 256, BK = 64, HALF = 128, HTB = HALF * BK * 2  , STAGE_BYTES = 8 * HTB, NXCD = 8, WGM = 8;
__host__ __device__ __forceinline__ int lds_byte(int r, int c) { const int st = (r >> 4) * 2 + (c >> 5), rr = r & 15, cc = c & 31, ob = rr * 64 + cc * 2; return st * 1024 + (ob ^ (((ob >> 9) & 1) << 5)); }
__host__ __device__ __forceinline__ void stage_rc(int b, int& R, int& C) { const int st = b / 1024, sb = b % 1024, swz = sb ^ (((sb >> 9) & 1) << 5); R = (st >> 1) * 16 + swz / 64; C = (st & 1) * 32 + (swz % 64) / 2; }
__host__ __device__ __forceinline__ int perm32(int rho) { const int n = rho >> 4, i = rho & 15; return 8 * (i >> 2) + 4 * n + (i & 3); }

struct Unit { int pm, pn, half; };
struct Gemm { const bf16_t* A; const bf16_t* Bt; int lda, ldb, K, a_pn_bytes; };

struct StaticOrder {
    int nN, nfull, grp, rank;
    __device__ void init(int N_, int bx) { nN = N_ / BM; nfull = nN / 4; grp = bx & 7; rank = bx >> 3; }
    __device__ bool next(int i, Unit& u) const {
        const bool halves = (nN & 3) == 2;
        if (halves && (rank & 1)) { if (i == 0) { half_unit(u); return true; } --i; if (i < nfull) { full_unit(i, u); return true; } return false; }
        if (i < nfull) { full_unit(i, u); return true; }
        if (i == nfull && halves) { half_unit(u); return true; }
        return false;
    }
    __device__ void full_unit(int i, Unit& u) const { const int l = i * 32 + rank; u.pm = 8 * grp + (l & 7); u.pn = l >> 3; u.half = 0; }
    __device__ void half_unit(Unit& u) const { u.pn = 4 * nfull + (rank >> 4); u.pm = 8 * grp + ((rank & 15) >> 1); u.half = 1 + (rank & 1); }
};


struct EpiSwiGLU {
    bf16_t* H; int ldh; const float* ssq; bool skip;
    __device__ __forceinline__ void prefetch(const Unit& u, int wr, int lane, float (&pre)[2]) const {
        const int rb = u.pm * BM + (u.half == 2 ? HALF : 0) + wr * 64 + lane;
        pre[0] = ssq[rb]; pre[1] = ssq[rb + HALF];
    }
    __device__ __forceinline__ void operator()(const f32x4 (&acc)[2][2][4][2], const Unit& u, int wr, int wc, int fr, int fq, const float (&pre)[2]) const {
        if (skip) return;
        const int row0 = u.pm * BM + (u.half == 2 ? HALF : 0) + wr * 64 + fr, col0 = u.pn * HALF + wc * 32 + 8 * fq;
#pragma unroll
        for (int ai = 0; ai < 2; ++ai) {
            if (ai == 1 && u.half != 0) break;
            const float rl = __builtin_amdgcn_rsqf(pre[ai] * (1.0f / D) + EPS);
#pragma unroll
            for (int m = 0; m < 4; ++m) {
                const float r = __shfl(rl, m * 16 + fr);
                const float c1 = r * -1.4426950408889634f, r2 = r * r;
                f32x2 h[4];
#pragma unroll
                for (int n = 0; n < 2; ++n)
#pragma unroll
                    for (int jp = 0; jp < 2; ++jp) {
                        const f32x2 g = (f32x2){acc[ai][0][m][n][2 * jp], acc[ai][0][m][n][2 * jp + 1]}, up = (f32x2){acc[ai][1][m][n][2 * jp], acc[ai][1][m][n][2 * jp + 1]};
                        const f32x2 t = g * c1;
                        f32x2 e; e.x = __builtin_amdgcn_exp2f(t.x); e.y = __builtin_amdgcn_exp2f(t.y);
                        const f32x2 d = e + 1.0f;
                        f32x2 q; q.x = __builtin_amdgcn_rcpf(d.x); q.y = __builtin_amdgcn_rcpf(d.y);
                        h[2 * n + jp] = (g * up) * (q * r2);
                    }
                u32x4 w; w.x = cvt_pk_bf16(h[0].x, h[0].y); w.y = cvt_pk_bf16(h[1].x, h[1].y); w.z = cvt_pk_bf16(h[2].x, h[2].y); w.w = cvt_pk_bf16(h[3].x, h[3].y);
                *(u32x4*)(H + (size_t)(row0 + ai * HALF + m * 16) * ldh + col0) = w;
            }
        }
    }
};
struct EpiGLU {
    bf16_t* V; const float* ssq; const float* bias;
    __device__ __forceinline__ void prefetch(const Unit& u, int wr, int lane, float (&pre)[2]) const {
        const int rb = u.pm * BM + wr * 64 + lane;
        pre[0] = ssq[rb]; pre[1] = ssq[rb + HALF];
    }
    __device__ __forceinline__ void operator()(const f32x4 (&acc)[2][2][4][2], const Unit& u, int wr, int wc, int fr, int fq, const float (&pre)[2]) const {
        const int row0 = u.pm * BM + wr * 64 + fr, col0 = u.pn * HALF + wc * 32 + 8 * fq;
        f32x4 ba[2], bg[2];
#pragma unroll
        for (int n = 0; n < 2; ++n) { ba[n] = *(const f32x4*)(bias + col0 + 4 * n); bg[n] = *(const f32x4*)(bias + D + col0 + 4 * n); }
#pragma unroll
        for (int ai = 0; ai < 2; ++ai) {
            const float rl = __builtin_amdgcn_rsqf(pre[ai] * (1.0f / D) + EPS);
#pragma unroll
            for (int m = 0; m < 4; ++m) {
                const float r = __shfl(rl, m * 16 + fr);
                const float c1 = r * -1.4426950408889634f;
                f32x2 h[4];
#pragma unroll
                for (int n = 0; n < 2; ++n)
#pragma unroll
                    for (int jp = 0; jp < 2; ++jp) {
                        const f32x2 av = (f32x2){acc[ai][0][m][n][2 * jp], acc[ai][0][m][n][2 * jp + 1]}, gv = (f32x2){acc[ai][1][m][n][2 * jp], acc[ai][1][m][n][2 * jp + 1]};
                        const f32x2 bav = (f32x2){ba[n][2 * jp], ba[n][2 * jp + 1]}, bgs = (f32x2){bg[n][2 * jp], bg[n][2 * jp + 1]} * -1.4426950408889634f;
                        const f32x2 t = gv * c1 + bgs;
                        f32x2 e; e.x = __builtin_amdgcn_exp2f(t.x); e.y = __builtin_amdgcn_exp2f(t.y);
                        const f32x2 d = e + 1.0f;
                        f32x2 q; q.x = __builtin_amdgcn_rcpf(d.x); q.y = __builtin_amdgcn_rcpf(d.y);
                        h[2 * n + jp] = (av * r + bav) * q;
                    }
                u32x4 w; w.x = cvt_pk_bf16(h[0].x, h[0].y); w.y = cvt_pk_bf16(h[1].x, h[1].y); w.z = cvt_pk_bf16(h[2].x, h[2].y); w.w = cvt_pk_bf16(h[3].x, h[3].y);
                *(u32x4*)(V + (size_t)(row0 + ai * HALF + m * 16) * D + col0) = w;
            }
        }
    }
};
struct EpiResid {
    const float* base; float* out; bf16_t* xb; const float* bias; float* ssq_out;
    __device__ __forceinline__ void prefetch(const Unit&, int, int, float (&pre)[2]) const { pre[0] = 0.f; pre[1] = 0.f; }
    __device__ __forceinline__ void operator()(const f32x4 (&acc)[2][2][4][2], const Unit& u, int wr, int wc, int fr, int fq, const float (&)[2]) const {
        const int row0 = u.pm * BM + wr * 64 + fr, col0 = u.pn * BM + wc * 32 + 8 * fq;
        f32x4 bv[2][2];
#pragma unroll
        for (int bj = 0; bj < 2; ++bj)
#pragma unroll
            for (int n = 0; n < 2; ++n) bv[bj][n] = bias ? *(const f32x4*)(bias + col0 + bj * HALF + 4 * n) : (f32x4){0.f, 0.f, 0.f, 0.f};
#pragma unroll
        for (int ai = 0; ai < 2; ++ai)
#pragma unroll
            for (int mp = 0; mp < 4; mp += 4) {
                f32x4 b[4][2][2];
#pragma unroll
                for (int mm = 0; mm < 4; ++mm)
#pragma unroll
                    for (int bj = 0; bj < 2; ++bj) { const size_t off = (size_t)(row0 + ai * HALF + (mp + mm) * 16) * D + col0 + bj * HALF;
                        b[mm][bj][0] = *(const f32x4*)(base + off); b[mm][bj][1] = *(const f32x4*)(base + off + 4); }
#pragma unroll
                for (int mm = 0; mm < 4; ++mm) {
                    const int m = mp + mm; const int row = row0 + ai * HALF + m * 16; const size_t off = (size_t)row * D + col0; float s = 0.f;
#pragma unroll
                    for (int bj = 0; bj < 2; ++bj) {
                        const f32x4 v0 = b[mm][bj][0] + acc[ai][bj][m][0] + bv[bj][0], v1 = b[mm][bj][1] + acc[ai][bj][m][1] + bv[bj][1];
                        *(f32x4*)(out + off + bj * HALF) = v0; *(f32x4*)(out + off + bj * HALF + 4) = v1;
                        u32x4 w; w.x = cvt_pk_bf16(v0[0], v0[1]); w.y = cvt_pk_bf16(v0[2], v0[3]); w.z = cvt_pk_bf16(v1[0], v1[1]); w.w = cvt_pk_bf16(v1[2], v1[3]);
                        if (xb) *(u32x4*)(xb + off + bj * HALF) = w;
                        s += (v0[0] * v0[0] + v0[1] * v0[1]) + (v0[2] * v0[2] + v0[3] * v0[3]) + (v1[0] * v1[0] + v1[1] * v1[1]) + (v1[2] * v1[2] + v1[3] * v1[3]);
                    }
                    s += __shfl_xor(s, 16); s += __shfl_xor(s, 32);
                    if (fq == 0) unsafeAtomicAdd(ssq_out + row, s);
                }
                asm volatile("" ::: "memory");
            }
    }
};
struct EpiFinal {
    const float* base; float* out; const float* gain; float* ssq_out; unsigned* pcnt; unsigned* tmo;
    __device__ __forceinline__ void prefetch(const Unit&, int, int, float (&pre)[2]) const { pre[0] = 0.f; pre[1] = 0.f; }
    __device__ __forceinline__ void operator()(f32x4 (&acc)[2][2][4][2], const Unit& u, int wr, int wc, int fr, int fq, const float (&)[2]) const {
        const int row0 = u.pm * BM + wr * 64 + fr, col0 = u.pn * BM + wc * 32 + 8 * fq;
#pragma unroll
        for (int ai = 0; ai < 2; ++ai)
#pragma unroll
            for (int mp = 0; mp < 4; mp += 4) {
                f32x4 b[4][2][2];
#pragma unroll
                for (int mm = 0; mm < 4; ++mm)
#pragma unroll
                    for (int bj = 0; bj < 2; ++bj) { const size_t off = (size_t)(row0 + ai * HALF + (mp + mm) * 16) * D + col0 + bj * HALF;
                        b[mm][bj][0] = *(const f32x4*)(base + off); b[mm][bj][1] = *(const f32x4*)(base + off + 4); }
#pragma unroll
                for (int mm = 0; mm < 4; ++mm) {
                    const int m = mp + mm; const int row = row0 + ai * HALF + m * 16; float s = 0.f;
#pragma unroll
                    for (int bj = 0; bj < 2; ++bj) {
                        const f32x4 v0 = b[mm][bj][0] + acc[ai][bj][m][0], v1 = b[mm][bj][1] + acc[ai][bj][m][1];
                        acc[ai][bj][m][0] = v0; acc[ai][bj][m][1] = v1;
                        s += (v0[0] * v0[0] + v0[1] * v0[1]) + (v0[2] * v0[2] + v0[3] * v0[3]) + (v1[0] * v1[0] + v1[1] * v1[1]) + (v1[2] * v1[2] + v1[3] * v1[3]);
                    }
                    s += __shfl_xor(s, 16); s += __shfl_xor(s, 32);
                    if (fq == 0) unsafeAtomicAdd(ssq_out + row, s);
                }
                asm volatile("" ::: "memory");
            }
        asm volatile("s_waitcnt vmcnt(0)" ::: "memory");
        unsigned* cnt = pcnt + 64 * u.pm;
        if ((threadIdx.x & 63) == 0) (void)__hip_atomic_fetch_add(cnt, 1u, __ATOMIC_RELAXED, __HIP_MEMORY_SCOPE_AGENT);
        { unsigned sp = 0;
          while ((unsigned)__builtin_amdgcn_readfirstlane((int)__hip_atomic_load(cnt, __ATOMIC_RELAXED, __HIP_MEMORY_SCOPE_AGENT)) < 32u) { __builtin_amdgcn_s_sleep(1);
              if ((++sp & 255u) == 0u) { if (__hip_atomic_load(tmo, __ATOMIC_RELAXED, __HIP_MEMORY_SCOPE_AGENT)) break; if (sp > (1u << 18)) { atomicAdd(tmo, 1u); break; } } } }
        f32x4 gv[2][2];
#pragma unroll
        for (int bj = 0; bj < 2; ++bj)
#pragma unroll
            for (int n = 0; n < 2; ++n) gv[bj][n] = *(const f32x4*)(gain + col0 + bj * HALF + 4 * n);
        float rs[2][4];
#pragma unroll
        for (int ai = 0; ai < 2; ++ai)
#pragma unroll
            for (int m = 0; m < 4; ++m) rs[ai][m] = __hip_atomic_load(ssq_out + row0 + ai * HALF + m * 16, __ATOMIC_RELAXED, __HIP_MEMORY_SCOPE_AGENT);
#pragma unroll
        for (int ai = 0; ai < 2; ++ai)
#pragma unroll
            for (int m = 0; m < 4; ++m) {
                const float r = __builtin_amdgcn_rsqf(rs[ai][m] * (1.0f / D) + EPS); const size_t off = (size_t)(row0 + ai * HALF + m * 16) * D + col0;
#pragma unroll
                for (int bj = 0; bj < 2; ++bj) {
                    __builtin_nontemporal_store(acc[ai][bj][m][0] * r * gv[bj][0], (f32x4*)(out + off + bj * HALF));
                    __builtin_nontemporal_store(acc[ai][bj][m][1] * r * gv[bj][1], (f32x4*)(out + off + bj * HALF + 4));
                }
            }
    }
};

template <class Epi, bool ALIGN_EPI>
__device__ __forceinline__ void gemm_phase(LAS unsigned char* lds, const Gemm g, const StaticOrder& S, const Epi& E, const int tid, const bool bpre) {
    const int wid = __builtin_amdgcn_readfirstlane(tid >> 6), lane = tid & 63, wr = wid >> 2, wc = wid & 3, fr = lane & 15, fq = lane >> 4;
    const int K = g.K, nt = K / BK;
    unsigned voffA[2], voffB[2];
#pragma unroll
    for (int i = 0; i < 2; ++i) { int R, C; stage_rc(tid * 16 + i * 8192, R, C); const int Rb = (R & ~31) + perm32(R & 31);
        voffA[i] = (unsigned)(R * g.lda + C) * 2u; voffB[i] = (unsigned)(Rb * g.ldb + C) * 2u; }
    const size_t kstep = (size_t)(BK * 2);
    const size_t hstepA = (size_t)HALF * g.lda * 2, hstepB = (size_t)HALF * g.ldb * 2;
    const size_t tstepA = 2 * hstepA, tstepB = 2 * hstepB;
    const unsigned ldsw = (unsigned)wid * 1024u;
    const int aoff = lds_byte(wr * 64 + fr, fq * 8), boff = lds_byte(wc * 32 + fr, fq * 8);
#define PG8_SA(b, h) (((b) * 2 + (h)) * HTB)
#define PG8_SB(b, h) ((4 + (b) * 2 + (h)) * HTB)
#define PG8_STAGE(bufoff, gbase, voff) do { _Pragma("unroll") for (int _i = 0; _i < 2; ++_i) \
        __builtin_amdgcn_global_load_lds((const unsigned*)((const char*)(gbase) + (voff)[_i]), (LAS unsigned*)(lds + (bufoff) + ldsw + _i * 8192), 16, 0, 0); } while (0)
#define PG8_LDA(dst, b, h) do { _Pragma("unroll") for (int m = 0; m < 4; ++m) _Pragma("unroll") for (int k = 0; k < 2; ++k) dst[m][k] = *(const LAS bf16x8*)(lds + PG8_SA(b, h) + aoff + m * 2048 + k * 1024); } while (0)
#define PG8_LDB(dst, b, h) do { _Pragma("unroll") for (int n = 0; n < 2; ++n) _Pragma("unroll") for (int k = 0; k < 2; ++k) dst[n][k] = *(const LAS bf16x8*)(lds + PG8_SB(b, h) + boff + n * 2048 + k * 1024); } while (0)
#define PG8_MMA(ai, bj, At, Bt) do { __builtin_amdgcn_s_setprio(1); _Pragma("unroll") for (int m = 0; m < 4; ++m) _Pragma("unroll") for (int n = 0; n < 2; ++n) _Pragma("unroll") for (int k = 0; k < 2; ++k) \
        acc[ai][bj][m][n] = __builtin_amdgcn_mfma_f32_16x16x32_bf16(Bt[n][k], At[m][k], acc[ai][bj][m][n], 0, 0, 0); __builtin_amdgcn_s_setprio(0); } while (0)
#define PG8_WAIT_V(n) asm volatile("s_waitcnt vmcnt(" #n ")" ::: "memory")
#define PG8_WAIT_L(n) asm volatile("s_waitcnt lgkmcnt(" #n ")" ::: "memory")
#define PG8_BAR __builtin_amdgcn_s_barrier()
#define PG8_SCHED __builtin_amdgcn_sched_barrier(0)
    Unit cur, nxt; int ui = 0;
    if (!S.next(0, cur)) return;
    f32x4 acc[2][2][4][2];
#pragma unroll
    for (int a = 0; a < 2; ++a)
#pragma unroll
        for (int b = 0; b < 2; ++b)
#pragma unroll
            for (int m = 0; m < 4; ++m)
#pragma unroll
                for (int n = 0; n < 2; ++n) acc[a][b][m][n] = (f32x4){0.f, 0.f, 0.f, 0.f};
    bf16x8 At[4][2], B0[2][2], B1[2][2];
    float pre[2]; E.prefetch(cur, wr, lane, pre);
    const char* cA = (const char*)g.A + (size_t)cur.pm * tstepA + (size_t)cur.pn * g.a_pn_bytes + (cur.half == 2 ? hstepA : (size_t)0); const char* cB = (const char*)g.Bt + (size_t)cur.pn * tstepB;
    if (bpre) {
        PG8_STAGE(PG8_SA(0, 0), cA, voffA); PG8_STAGE(PG8_SA(0, 1), cA + hstepA, voffA);
        if (wr == 1) PG8_BAR;
        PG8_WAIT_V(2); PG8_BAR;
        PG8_STAGE(PG8_SA(1, 0), cA + kstep, voffA);
        PG8_WAIT_V(2); PG8_BAR;
    } else {
    PG8_STAGE(PG8_SB(0, 0), cB, voffB); PG8_STAGE(PG8_SB(0, 1), cB + hstepB, voffB); PG8_STAGE(PG8_SA(0, 0), cA, voffA); PG8_STAGE(PG8_SA(0, 1), cA + hstepA, voffA);
    if (wr == 1) PG8_BAR;
    PG8_WAIT_V(2); PG8_BAR;
    PG8_STAGE(PG8_SB(1, 0), cB + kstep, voffB); PG8_STAGE(PG8_SA(1, 0), cA + kstep, voffA); PG8_STAGE(PG8_SB(1, 1), cB + hstepB + kstep, voffB);
    PG8_WAIT_V(6); PG8_BAR;
    }
    for (;;) {
        const bool has_next = S.next(ui + 1, nxt);
        const char* nA = has_next ? (const char*)g.A + (size_t)nxt.pm * tstepA + (size_t)nxt.pn * g.a_pn_bytes + (nxt.half == 2 ? hstepA : (size_t)0) : cA;
        const bool full = (cur.half == 0); const char* nB = has_next ? (const char*)g.Bt + (size_t)nxt.pn * tstepB : cB;
        for (int t = 0; t < nt; t += 2) {
            const bool last = (t == nt - 2);
            const char* a1 = cA + (size_t)(t + 1) * kstep;
            const char* a2 = last ? nA : cA + (size_t)(t + 2) * kstep; const char* b2 = last ? nB : cB + (size_t)(t + 2) * kstep;
            const char* a3 = a2 + kstep; const char* b3 = b2 + kstep;
            PG8_LDB(B0, 0, 0); PG8_LDB(B1, 0, 1); PG8_SCHED; PG8_LDA(At, 0, 0); PG8_STAGE(PG8_SA(1, 1), a1 + hstepA, voffA);
            PG8_WAIT_V(8); PG8_WAIT_L(0); PG8_BAR; PG8_MMA(0, 0, At, B0); PG8_MMA(0, 1, At, B1); PG8_BAR; PG8_SCHED;
            if (full) PG8_LDA(At, 0, 1); PG8_STAGE(PG8_SB(0, 0), b2, voffB); PG8_STAGE(PG8_SB(0, 1), b2 + hstepB, voffB); PG8_STAGE(PG8_SA(0, 0), a2, voffA);
            PG8_WAIT_V(8); PG8_WAIT_L(0); PG8_BAR; if (full) { PG8_MMA(1, 0, At, B0); PG8_MMA(1, 1, At, B1); } PG8_BAR; PG8_SCHED;
            PG8_LDB(B0, 1, 0); PG8_LDB(B1, 1, 1); PG8_SCHED; PG8_LDA(At, 1, 0); PG8_STAGE(PG8_SA(0, 1), a2 + hstepA, voffA);
            PG8_WAIT_V(8); PG8_WAIT_L(0); PG8_BAR; PG8_MMA(0, 0, At, B0); PG8_MMA(0, 1, At, B1); PG8_BAR; PG8_SCHED;
            if (full) PG8_LDA(At, 1, 1); PG8_STAGE(PG8_SB(1, 0), b3, voffB); PG8_STAGE(PG8_SB(1, 1), b3 + hstepB, voffB); PG8_STAGE(PG8_SA(1, 0), a3, voffA);
            PG8_WAIT_V(8); PG8_WAIT_L(0); PG8_BAR; if (full) { PG8_MMA(1, 0, At, B0); PG8_MMA(1, 1, At, B1); } PG8_BAR; PG8_SCHED;
        }
        if constexpr (ALIGN_EPI) { if (wr == 0) PG8_BAR; }
        E(acc, cur, wr, wc, fr, fq, pre);
        if (!has_next) break;
        E.prefetch(nxt, wr, lane, pre);
#pragma unroll
        for (int a = 0; a < 2; ++a)
#pragma unroll
            for (int b = 0; b < 2; ++b)
#pragma unroll
                for (int m = 0; m < 4; ++m)
#pragma unroll
                    for (int n = 0; n < 2; ++n) acc[a][b][m][n] = (f32x4){0.f, 0.f, 0.f, 0.f};
        cur = nxt; cA = nA; cB = nB; ++ui;
        if constexpr (ALIGN_EPI) { if (wr == 1) PG8_BAR; }
    }
    PG8_WAIT_V(0);
    if constexpr (!ALIGN_EPI) { if (wr == 0) PG8_BAR; }
    PG8_BAR;
#undef PG8_SA
#undef PG8_SB
#undef PG8_STAGE
#undef PG8_LDA
#undef PG8_LDB
#undef PG8_MMA
#undef PG8_WAIT_V
#undef PG8_WAIT_L
#undef PG8_BAR
#undef PG8_SCHED
}
__device__ __forceinline__ void gemm_preissue_B(LAS unsigned char* lds, const bf16_t* Bt, int ldb, int pn, const int tid) {
    const int wid = __builtin_amdgcn_readfirstlane(tid >> 6);
    const size_t hstepB = (size_t)HALF * ldb * 2, kstep = (size_t)(BK * 2);
    const char* cB = (const char*)Bt + (size_t)pn * 2 * hstepB;
    const unsigned ldsw = (unsigned)wid * 1024u;
#pragma unroll
    for (int i = 0; i < 2; ++i) { int R, C; stage_rc(tid * 16 + i * 8192, R, C); const int Rb = (R & ~31) + perm32(R & 31);
        const unsigned vo = (unsigned)(Rb * ldb + C) * 2u;
        __builtin_amdgcn_global_load_lds((const unsigned*)(cB + vo), (LAS unsigned*)(lds + (4 + 0) * HTB + ldsw + i * 8192), 16, 0, 0);
        __builtin_amdgcn_global_load_lds((const unsigned*)(cB + hstepB + vo), (LAS unsigned*)(lds + (4 + 1) * HTB + ldsw + i * 8192), 16, 0, 0);
        __builtin_amdgcn_global_load_lds((const unsigned*)(cB + kstep + vo), (LAS unsigned*)(lds + (4 + 2) * HTB + ldsw + i * 8192), 16, 0, 0);
        __builtin_amdgcn_global_load_lds((const unsigned*)(cB + hstepB + kstep + vo), (LAS unsigned*)(lds + (4 + 3) * HTB + ldsw + i * 8192), 16, 0, 0); }
}
}

#define XB_TMO      128
#define XB_XCNT(j)  (256  + 64 * (j))
#define XB_XSUB(j)  (1280 + 64 * (j))
#define XB_XGEN(j)  (2304 + 64 * (j))
#define XB_TOP      3328
#define XB_TOPGEN   3392
#define XCD_BAR_WORDS 3456
#define XB_SPIN_CAP (1u << 18)
__device__ __forceinline__ unsigned xb_ld(unsigned* p)              { return __hip_atomic_load(p, __ATOMIC_RELAXED, __HIP_MEMORY_SCOPE_AGENT); }
__device__ __forceinline__ unsigned xb_add(unsigned* p, unsigned v) { return __hip_atomic_fetch_add(p, v, __ATOMIC_RELAXED, __HIP_MEMORY_SCOPE_AGENT); }
__device__ __forceinline__ unsigned xb_xcc_id() { return (unsigned)__builtin_amdgcn_s_getreg((3 << 11) | 20) & 0xFu; }
#define XB_SPIN(cond, bar) do { unsigned _sp = 0; while (cond) { __builtin_amdgcn_s_sleep(1); \
    if ((++_sp & 255u) == 0u) { if (xb_ld(&(bar)[XB_TMO])) break; if (_sp > XB_SPIN_CAP) { atomicAdd(&(bar)[XB_TMO], 1u); break; } } } } while (0)
struct XcdBarrier { unsigned* bar; unsigned x; volatile LAS unsigned* st; };
__device__ __forceinline__ XcdBarrier xcd_barrier_post(unsigned* bar, volatile LAS unsigned* st) {
    XcdBarrier b; b.bar = bar; b.x = xb_xcc_id(); b.st = st;
    if (threadIdx.x == 0) (void)xb_add(&bar[XB_XCNT(b.x)], 1u);
    return b;
}
__device__ __forceinline__ void xcd_barrier_complete(unsigned* bar, unsigned x, unsigned& nloc, unsigned& nx) {
    const unsigned G = gridDim.x * gridDim.y * gridDim.z;
    unsigned sum, cnt, mine, sp = 0u;
    for (;;) {
        sum = 0u; cnt = 0u; mine = 0u;
#pragma unroll
        for (unsigned j = 0; j < 16; ++j) { const unsigned c = xb_ld(&bar[XB_XCNT(j)]); sum += c; cnt += (c > 0u) ? 1u : 0u; mine = (j == x) ? c : mine; }
        if (sum == G) break;
        __builtin_amdgcn_s_sleep(1);
        if ((++sp & 255u) == 0u) { if (xb_ld(&bar[XB_TMO])) break; if (sp > XB_SPIN_CAP) { atomicAdd(&bar[XB_TMO], 1u); break; } }
    }
    nloc = mine > 0u ? mine : 1u; nx = cnt > 0u ? cnt : 1u;
}
__device__ __forceinline__ void xcd_barrier(const XcdBarrier& b) {
    asm volatile("s_waitcnt vmcnt(0)" ::: "memory");
    __syncthreads();
    if (threadIdx.x == 0) {
        unsigned* bar = b.bar;
        __builtin_amdgcn_s_waitcnt(0);
        unsigned nloc = b.st[0], nx = b.st[1];
        if (nloc == 0u) { xcd_barrier_complete(bar, b.x, nloc, nx); b.st[0] = nloc; b.st[1] = nx; }
        const unsigned old = xb_add(&bar[XB_XSUB(b.x)], 1u);
        const unsigned gen = old / nloc;
        if (old + 1u == (gen + 1u) * nloc) {
            __builtin_amdgcn_fence(__ATOMIC_RELEASE, "agent");
            asm volatile("s_waitcnt vmcnt(0)" ::: "memory");
            const unsigned og = xb_add(&bar[XB_TOP], 1u);
            const unsigned tg = og / nx;
            if (og + 1u == (tg + 1u) * nx) xb_add(&bar[XB_TOPGEN], 1u);
            else XB_SPIN(xb_ld(&bar[XB_TOPGEN]) == tg, bar);
            __builtin_amdgcn_fence(__ATOMIC_ACQUIRE, "agent");
            xb_add(&bar[XB_XGEN(b.x)], 1u);
            asm volatile("s_waitcnt vmcnt(0)" ::: "memory");
        } else {
            XB_SPIN(xb_ld(&bar[XB_XGEN(b.x)]) == gen, bar);
            __builtin_amdgcn_fence(__ATOMIC_ACQUIRE, "agent");
            asm volatile("s_waitcnt vmcnt(0)" ::: "memory");
        }
    }
    __syncthreads();
}

constexpr int CW_GMASK = 512, CW_GCNT = 1024, CW_GTMO = 2048, CW_PCNT = 8192;
__device__ __forceinline__ void group_barrier_arrive(unsigned* ctl, int grp) {
    asm volatile("s_waitcnt vmcnt(0)" ::: "memory");
    __syncthreads();
    if (threadIdx.x == 0) { __builtin_amdgcn_s_waitcnt(0); (void)xb_add(ctl + CW_GCNT + 64 * grp, 1u); }
}
__device__ __forceinline__ void group_barrier_wait(unsigned* ctl, int grp, unsigned target) {
    if (threadIdx.x == 0) {
        unsigned* cnt = ctl + CW_GCNT + 64 * grp;
        unsigned sp = 0;
        while (xb_ld(cnt) < target) { __builtin_amdgcn_s_sleep(1);
            if ((++sp & 255u) == 0u) { if (xb_ld(ctl + CW_GTMO)) break; if (sp > XB_SPIN_CAP) { atomicAdd(ctl + CW_GTMO, 1u); break; } } }
        __builtin_amdgcn_fence(__ATOMIC_ACQUIRE, "agent");
        asm volatile("s_waitcnt vmcnt(0)" ::: "memory");
    }
    __syncthreads();
}

struct Args { const float* in[17]; float* out; unsigned char* ws; int ph_lo, ph_hi; };

__device__ __forceinline__ void p0_item(const float* src, int lds_, bf16_t* dst, int Kdst, const float* gk, const float* sn, float cst, LAS float* scr, int lane) {
    f32x4 v[16];
#pragma unroll
    for (int i = 0; i < 16; ++i) v[i] = __builtin_nontemporal_load((const f32x4*)(src + (size_t)(4 * i + (lane >> 4)) * lds_ + 4 * (lane & 15)));
#pragma unroll
    for (int i = 0; i < 16; ++i) { LAS float* p = scr + (4 * i + (lane >> 4)) * 65 + 4 * (lane & 15); p[0] = v[i][0]; p[1] = v[i][1]; p[2] = v[i][2]; p[3] = v[i][3]; }
    const int c = lane & 7, r = lane >> 3;
    float gs[8];
#pragma unroll
    for (int i = 0; i < 8; ++i) gs[i] = (gk ? gk[8 * c + i] : 1.0f) * cst;
    LDS_WAIT(); asm volatile("" ::: "memory");
#pragma unroll
    for (int j = 0; j < 8; ++j) {
        const int n = r + 8 * j; const float s = sn ? sn[n] : 1.0f; const LAS float* p = scr + (8 * c) * 65 + n;
        float x[8];
#pragma unroll
        for (int i = 0; i < 8; ++i) x[i] = p[i * 65] * gs[i] * s;
        u32x4 o; o.x = cvt_pk_bf16(x[0], x[1]); o.y = cvt_pk_bf16(x[2], x[3]); o.z = cvt_pk_bf16(x[4], x[5]); o.w = cvt_pk_bf16(x[6], x[7]);
        __builtin_nontemporal_store(o, (u32x4*)(dst + (size_t)n * Kdst + 8 * c));
    }
    LDS_WAIT(); asm volatile("" ::: "memory");
}
constexpr int I_FFN1 = 16 * 44, I_FFN = 3 * I_FFN1, I_FFN_ALL = 8 * I_FFN;
constexpr int I_CIN = 16 * 32, I_COUT = 16 * 16, I_CONV = I_CIN + I_COUT, I_CONV_ALL = 2 * I_CONV;
constexpr int I_POOL = 4 * 16, I_POOL_ALL = 2 * I_POOL;
constexpr int I_ALL = I_FFN_ALL + I_CONV_ALL + I_POOL_ALL;
__device__ __forceinline__ void p0_prologue(const Args& a, LAS unsigned char* lds, int vcu, int G, int wave, int lane) {
    LAS float* scr = (LAS float*)(lds + wave * (64 * 65 * 4));
    const int gw = vcu * NWAVES + wave, NGW = G * NWAVES;
    unsigned char* ws = a.ws;
    for (int it0 = gw; it0 < I_ALL; it0 += NGW) {
        int it = it0;
        if (it < I_FFN_ALL) {
            const int f = it / I_FFN, r = it % I_FFN, ty = r / I_FFN1, q = r % I_FFN1;
            if (ty < 2) {
                const int kb = q / 44, nb = q % 44, k0 = 64 * kb, n0 = 64 * nb;
                const float* src = (ty == 0 ? a.in[2] : a.in[3]) + (size_t)f * D * FF + (size_t)k0 * FF + n0;
                const int R0 = 256 * (n0 / 128) + 128 * ty + (n0 % 128);
                bf16_t* dst = (bf16_t*)(ws + WS_WGU) + (size_t)f * 2 * FF * D + (size_t)R0 * D + k0;
                p0_item(src, FF, dst, D, a.in[1] + f * D + k0, nullptr, 1.0f, scr, lane);
            } else {
                const int kb = q / 16, nb = q % 16, k0 = 64 * kb, n0 = 64 * nb;
                const float* src = a.in[4] + (size_t)f * FF * D + (size_t)k0 * D + n0;
                bf16_t* dst = (bf16_t*)(ws + WS_WD) + (size_t)f * D * FF + (size_t)n0 * FF + k0;
                p0_item(src, D, dst, FF, nullptr, nullptr, 0.5f, scr, lane);
            }
            continue;
        }
        it -= I_FFN_ALL;
        if (it < I_CONV_ALL) {
            const int j = it / I_CONV, r = it % I_CONV;
            if (r < I_CIN) {
                const int kb = r / 32, nb = r % 32, k0 = 64 * kb, n0 = 64 * nb, which = n0 / D, cc = n0 % D;
                const float* src = a.in[6] + (size_t)j * D * 2 * D + (size_t)k0 * 2 * D + n0;
                const int R0 = 256 * (cc / 128) + 128 * which + (cc % 128);
                bf16_t* dst = (bf16_t*)(ws + WS_WIN) + (size_t)j * 2 * D * D + (size_t)R0 * D + k0;
                p0_item(src, 2 * D, dst, D, a.in[5] + (2 * j) * D + k0, nullptr, 1.0f, scr, lane);
            } else {
                const int rr = r - I_CIN, kb = rr / 16, nb = rr % 16, k0 = 64 * kb, n0 = 64 * nb;
                const float* src = a.in[12] + (size_t)j * D * D + (size_t)k0 * D + n0;
                bf16_t* dst = (bf16_t*)(ws + WS_WOUT) + (size_t)j * D * D + (size_t)n0 * D + k0;
                p0_item(src, D, dst, D, nullptr, nullptr, 1.0f, scr, lane);
            }
            continue;
        }
        it -= I_CONV_ALL;
        {
            const int j = it / I_POOL, r = it % I_POOL, gp = r / 16, rr = r % 16, kb = rr / 4, nb = rr % 4, k0 = 64 * kb, n0 = 64 * nb;
            const float* src = a.in[14] + (size_t)(j * 4 + gp) * 256 * 256 + (size_t)k0 * 256 + n0;
            bf16_t* dst = (bf16_t*)(ws + WS_WP) + (size_t)j * D * 256 + (size_t)(gp * 256 + n0) * 256 + k0;
            p0_item(src, 256, dst, 256, a.in[5] + (2 * j + 1) * D + gp * 256 + k0, a.in[15] + j * D + gp * 256 + n0, 1.0f, scr, lane);
        }
    }
    const float* x = a.in[0]; bf16_t* XB = (bf16_t*)(ws + WS_XB); float* ssq0 = (float*)(ws + WS_SSQ);
    for (int mi = 0; mi < 8; ++mi) {
        const int m = 64 * vcu + 8 * wave + mi;
        const f32x4* xr = (const f32x4*)(x + (size_t)m * D) + lane;
        f32x4 v[4]; float s = 0.f;
#pragma unroll
        for (int j = 0; j < 4; ++j) { v[j] = __builtin_nontemporal_load(xr + 64 * j); s += (v[j][0] * v[j][0] + v[j][1] * v[j][1]) + (v[j][2] * v[j][2] + v[j][3] * v[j][3]); }
        s = wave_sum(s);
        u32x2* o8 = (u32x2*)(XB + (size_t)m * D) + lane;
#pragma unroll
        for (int j = 0; j < 4; ++j) { u32x2 w; w.x = cvt_pk_bf16(v[j][0], v[j][1]); w.y = cvt_pk_bf16(v[j][2], v[j][3]); o8[64 * j] = w; }
        if (lane == 0) ssq0[m] = s;
    }
}

__device__ __forceinline__ void final_phase(float* xo, const float* ssq, const float* gain, int vcu, int G, int wave, int lane) {
    f32x4 gv[4];
#pragma unroll
    for (int j = 0; j < 4; ++j) gv[j] = ((const f32x4*)gain)[lane + 64 * j];
    for (int mi = 0; mi < 8; ++mi) {
        const int m = 64 * vcu + 8 * wave + mi;
        f32x4* xr = (f32x4*)(xo + (size_t)m * D) + lane;
        const float r = __builtin_amdgcn_rsqf(__hip_atomic_load(ssq + m, __ATOMIC_RELAXED, __HIP_MEMORY_SCOPE_AGENT) * (1.0f / D) + EPS);
        f32x4 v[4];
#pragma unroll
        for (int j = 0; j < 4; ++j) v[j] = __builtin_nontemporal_load(xr + 64 * j);
#pragma unroll
        for (int j = 0; j < 4; ++j) __builtin_nontemporal_store(v[j] * r * gv[j], xr + 64 * j);
    }
}

template <int W>
__device__ __forceinline__ void pool_chunk(const float* x, const float* ssq, bf16_t* P, int m0, int t0, int tid, int lane) {
    const int c = 2 * tid;
    f32x2 buf[W];
#pragma unroll
    for (int i = 0; i < W; ++i) buf[i] = (f32x2){0.f, 0.f};
    f32x2 S = (f32x2){0.f, 0.f};
    if (t0 > 0) {
        const float sq = ssq[m0 - 16 + (lane & 15)];
        const float rl = __builtin_amdgcn_rsqf(sq * (1.0f / D) + EPS);
#pragma unroll
        for (int i = 1; i < W; ++i) {
            const float r = __shfl(rl, 16 - W + i);
            const f32x2 v = *(const f32x2*)(x + (size_t)(m0 - W + i) * D + c) * r;
            buf[i] = v; S += v;
        }
    }
#pragma unroll 1
    for (int rb = 0; rb < 64; rb += 16) {
        const float sq = ssq[m0 + rb + (lane & 15)];
        const float rl = __builtin_amdgcn_rsqf(sq * (1.0f / D) + EPS);
        f32x2 v[16];
#pragma unroll
        for (int i = 0; i < 16; ++i) v[i] = *(const f32x2*)(x + (size_t)(m0 + rb + i) * D + c);
#pragma unroll
        for (int i = 0; i < 16; ++i) {
            const float r = __shfl(rl, i);
            const f32x2 hv = v[i] * r;
            S += hv - buf[i % W]; buf[i % W] = hv;
            const int t = t0 + rb + i; const float inv = 1.0f / (float)((t + 1) < W ? (t + 1) : W);
            const f32x2 p = S * inv - hv;
            *(unsigned*)(P + (size_t)(m0 + rb + i) * D + c) = cvt_pk_bf16(p[0], p[1]);
        }
    }
}
__device__ __forceinline__ void pool_phase(const float* x, const float* ssq, bf16_t* P, int vcu, int G, int tid, int wave, int lane) {
    {
        const int ch = vcu;
        const int m0 = 64 * ch, t0 = m0 % SEQ; const int gsel = wave >> 1;
        if (gsel == 0) pool_chunk<2>(x, ssq, P, m0, t0, tid, lane);
        else if (gsel == 1) pool_chunk<4>(x, ssq, P, m0, t0, tid, lane);
        else if (gsel == 2) pool_chunk<8>(x, ssq, P, m0, t0, tid, lane);
        else pool_chunk<16>(x, ssq, P, m0, t0, tid, lane);
    }
}

constexpr int CV_ROWS = 32, CV_HALO = CONVW - 1, CV_LROWS = CV_ROWS + CV_HALO  , CV_RED_OFF = CV_LROWS * D * 2  ;
__device__ __forceinline__ void conv_phase(const bf16_t* V, bf16_t* C, const float* dw, const float* dwb, const float* lng, const float* lnb, LAS unsigned char* lds, int vcu, int G, int tid, int wave, int lane) {
    const int c = 128 * wave + 2 * lane;
    f32x2 w[CONVW];
#pragma unroll
    for (int k = 0; k < CONVW; ++k) w[k] = *(const f32x2*)(dw + k * D + c);
    const f32x2 bconv = *(const f32x2*)(dwb + c), gg = *(const f32x2*)(lng + c), bb = *(const f32x2*)(lnb + c);
    LAS f32x2* red = (LAS f32x2*)(lds + CV_RED_OFF);
    for (int ck = 0; ck < 2; ++ck) {
        const int ch = 2 * vcu + ck;
        const int m0 = CV_ROWS * ch, t0 = m0 % SEQ;
        {
            u32x4 st[16];
#pragma unroll
            for (int i = 0; i < 16; ++i) { const int p = tid + 512 * i, j = p >> 7, off = (p & 127) * 8;
                st[i] = (u32x4){0u, 0u, 0u, 0u};
                if (p < CV_LROWS * 128 && (t0 + j - CV_HALO) >= 0) st[i] = *(const u32x4*)(V + (size_t)(m0 + j - CV_HALO) * D + off); }
#pragma unroll
            for (int i = 0; i < 16; ++i) { const int p = tid + 512 * i; if (p < CV_LROWS * 128) *(LAS u32x4*)(lds + (size_t)p * 16) = st[i]; }
        }
        LDS_WAIT(); __syncthreads();
#pragma unroll 1
        for (int hf = 0; hf < 2; ++hf) {
            f32x2 y[16];
            const LAS unsigned char* lp = lds + c * 2 + hf * 16 * (D * 2);
#pragma unroll
            for (int q = 0; q < 2; ++q) {
                f32x2 ac[8];
#pragma unroll
                for (int i = 0; i < 8; ++i) ac[i] = bconv;
#pragma unroll
                for (int jj = 0; jj < 38; ++jj) {
                    const unsigned u = *(const LAS unsigned*)(lp + (8 * q + jj) * (D * 2));
                    const f32x2 v = (f32x2){bf_lo(u), bf_hi(u)};
#pragma unroll
                    for (int i = 0; i < 8; ++i) { const int k = jj - i; if (k >= 0 && k <= 30) ac[i] += w[k] * v; }
                }
#pragma unroll
                for (int i = 0; i < 8; ++i) y[8 * q + i] = ac[i];
            }
            {
                const bool b5 = (lane & 32) != 0, b4 = (lane & 16) != 0, b3 = (lane & 8) != 0, b2 = (lane & 4) != 0, b1 = (lane & 2) != 0;
                float x16[16], x8[8], x4[4], x2[2], x1;
#pragma unroll
                for (int i = 0; i < 16; ++i) { const float s1 = y[i][0] + y[i][1], s2 = y[i][0] * y[i][0] + y[i][1] * y[i][1];
                    const float snd = b5 ? s1 : s2, kp = b5 ? s2 : s1; x16[i] = kp + __shfl_xor(snd, 32); }
#pragma unroll
                for (int i = 0; i < 8; ++i) { const float snd = b4 ? x16[i] : x16[8 + i], kp = b4 ? x16[8 + i] : x16[i]; x8[i] = kp + __shfl_xor(snd, 16); }
#pragma unroll
                for (int i = 0; i < 4; ++i) { const float snd = b3 ? x8[i] : x8[4 + i], kp = b3 ? x8[4 + i] : x8[i]; x4[i] = kp + __shfl_xor(snd, 8); }
#pragma unroll
                for (int i = 0; i < 2; ++i) { const float snd = b2 ? x4[i] : x4[2 + i], kp = b2 ? x4[2 + i] : x4[i]; x2[i] = kp + __shfl_xor(snd, 4); }
                { const float snd = b1 ? x2[0] : x2[1], kp = b1 ? x2[1] : x2[0]; x1 = kp + __shfl_xor(snd, 2); }
                x1 += __shfl_xor(x1, 1);
                if ((lane & 1) == 0) ((LAS float*)red)[(((hf * 16 + ((lane >> 1) & 15)) * 8 + wave) << 1) + (b5 ? 1 : 0)] = x1;
            }
            LDS_WAIT(); __syncthreads();
            float mean_l = 0.f, rstd_l = 0.f;
            if (lane < 16) {
                float s1 = 0.f, s2 = 0.f;
#pragma unroll
                for (int k = 0; k < 8; ++k) { const f32x2 p = red[(hf * 16 + lane) * 8 + k]; s1 += p[0]; s2 += p[1]; }
                mean_l = s1 * (1.0f / D); const float var = s2 * (1.0f / D) - mean_l * mean_l;
                rstd_l = __builtin_amdgcn_rsqf((var > 0.f ? var : 0.f) + EPS);
            }
#pragma unroll
            for (int o = 0; o < 16; ++o) {
                const float mean = __builtin_bit_cast(float, __builtin_amdgcn_readlane(__builtin_bit_cast(int, mean_l), o)), rstd = __builtin_bit_cast(float, __builtin_amdgcn_readlane(__builtin_bit_cast(int, rstd_l), o));
                const f32x2 z = (y[o] - mean) * rstd * gg + bb;
                const float o0 = z[0] * fast_sigmoid(z[0]), o1 = z[1] * fast_sigmoid(z[1]);
                *(unsigned*)(C + (size_t)(m0 + hf * 16 + o) * D + c) = cvt_pk_bf16(o0, o1);
            }
        }
        __syncthreads();
    }
    __syncthreads();
}

__device__ __forceinline__ void decode_phase(int ph, int& ty, int& L, int& s) {
    L = 0; s = 0;
    if (ph == 0) { ty = 0; return; }
    if (ph >= 27) { ty = 8; return; }
    const int q = ph - 1; int r;
    if (q < 7) { L = 0; r = q; } else if (q < 13) { L = 1; r = q - 7; } else if (q < 20) { L = 2; r = q - 13; } else { L = 3; r = q - 20; }
    if ((L & 1) == 0) { ty = (r == 0 || r == 5) ? 1 : (r == 1 || r == 6) ? 2 : (r == 2) ? 3 : (r == 3) ? 4 : 5; s = (r >= 5) ? 1 : 0; }
    else { ty = (r == 0 || r == 4) ? 1 : (r == 1 || r == 5) ? 2 : (r == 2) ? 6 : 7; s = (r >= 4) ? 1 : 0; }
}
__global__ void __launch_bounds__(NWAVES * 64, 2) trunk_fwd(Args args) {
    extern __shared__ __attribute__((aligned(16))) unsigned char lds_raw[];
    LAS unsigned char* lds = (LAS unsigned char*)lds_raw;
    const int tid0 = threadIdx.x;
    const int G = gridDim.x; const int bx = blockIdx.x; const int vcu = (G % 8 == 0) ? (bx % 8) * (G / 8) + bx / 8 : bx;
    unsigned char* ws = args.ws;
    volatile LAS unsigned* MISC = (volatile LAS unsigned*)(lds + LDSCTL_OFF);
    for (int u = tid0; u < (LDS_BYTES - LDSCTL_OFF) / 4; u += NWAVES * 64) MISC[u] = 0u;
    __syncthreads();
#if !MK_PER_PHASE
    XcdBarrier bar = xcd_barrier_post((unsigned*)(ws + WS_CTL) + CW_BAR, MISC + 8);
    if (tid0 == 0) atomicOr((unsigned*)(ws + WS_CTL) + CW_GMASK + 64 * (bx & 7), 1u << xb_xcc_id());
    unsigned fast = 0u, gb_epoch = 0u;
#endif
    bf16_t* const XB = (bf16_t*)(ws + WS_XB); bf16_t* const HB = (bf16_t*)(ws + WS_H);
    bf16_t* const VB = (bf16_t*)(ws + WS_V); bf16_t* const CB = (bf16_t*)(ws + WS_C); bf16_t* const PB = (bf16_t*)(ws + WS_P);
    float* const SSQ = (float*)(ws + WS_SSQ);
    float* const xo = args.out;

    const int lo = args.ph_lo, hi = args.ph_hi;
    bool bpre = false;
#pragma unroll 1
    for (int ph = lo; ph < hi; ++ph) {
        int ty, L, s; decode_phase(ph, ty, L, s);
        const int f = 2 * L + s, j = L >> 1;
#if PROBE_MASK
        const int nrep = ((PROBE_MASK >> ty) & 1) ? 2 : 1;
#pragma unroll 1
        for (int rep = 0; rep < nrep; ++rep) {
        const bool dummy = (rep == 1);
#else
        {
        const bool dummy = false;
#endif
        int tid = tid0; asm volatile("" : "+v"(tid));
        const int lane = tid & 63, wave = __builtin_amdgcn_readfirstlane(tid >> 6);
        float* const o_f32 = dummy ? (float*)(ws + WS_END) : xo; bf16_t* const o_xb = dummy ? (bf16_t*)(ws + WS_END) : XB;
        if (ty == 0) {
            p0_prologue(args, lds, vcu, G, wave, lane);
        } else if (ty == 1) {
            pg8::Gemm g{XB, (const bf16_t*)(ws + WS_WGU) + (size_t)f * 2 * FF * D, D, D, D, 0};
            pg8::StaticOrder S; S.init(2 * FF, bx);
            pg8::EpiSwiGLU E{HB, FF, SSQ + (size_t)(3 * L + 2 * s) * M, dummy};
            pg8::gemm_phase<pg8::EpiSwiGLU, true>(lds, g, S, E, tid, bpre);
        } else if (ty == 2) {
            pg8::Gemm g{HB, (const bf16_t*)(ws + WS_WD) + (size_t)f * D * FF, FF, FF, FF, 0};
            pg8::StaticOrder S; S.init(D, bx);
            if (L == DEPTH - 1 && s == 1 && !dummy) {
                pg8::StaticOrder S2; S2.init(D, bx);
                pg8::EpiFinal EF{xo, xo, args.in[16], SSQ + (size_t)12 * M, (unsigned*)(ws + WS_CTL) + CW_PCNT, (unsigned*)(ws + WS_CTL) + CW_GTMO};
                pg8::gemm_phase<pg8::EpiFinal, true>(lds, g, S2, EF, tid, bpre);
            } else {
            const bool xb_dead = ((L & 1) == 1 && s == 0) || (L == DEPTH - 1 && s == 1);
            pg8::EpiResid E{(f == 0) ? args.in[0] : xo, o_f32, xb_dead ? (bf16_t*)nullptr : o_xb, nullptr, SSQ + (size_t)(dummy ? 14 : 3 * L + 2 * s + 1) * M};
            pg8::gemm_phase<pg8::EpiResid, true>(lds, g, S, E, tid, bpre);
            }
        } else if (ty == 3) {
            pg8::Gemm g{XB, (const bf16_t*)(ws + WS_WIN) + (size_t)j * 2 * D * D, D, D, D, 0};
            pg8::StaticOrder S; S.init(2 * D, bx);
            pg8::EpiGLU E{VB, SSQ + (size_t)(3 * L + 1) * M, args.in[7] + (size_t)j * 2 * D};
            pg8::gemm_phase<pg8::EpiGLU, true>(lds, g, S, E, tid, bpre);
        } else if (ty == 4) {
            conv_phase(VB, CB, args.in[8] + (size_t)j * CONVW * D, args.in[9] + j * D, args.in[10] + j * D, args.in[11] + j * D, lds, vcu, G, tid, wave, lane);
        } else if (ty == 5) {
            pg8::Gemm g{CB, (const bf16_t*)(ws + WS_WOUT) + (size_t)j * D * D, D, D, D, 0};
            pg8::StaticOrder S; S.init(D, bx);
            pg8::EpiResid E{xo, o_f32, o_xb, args.in[13] + j * D, SSQ + (size_t)(dummy ? 14 : 3 * L + 2) * M};
            pg8::gemm_phase<pg8::EpiResid, true>(lds, g, S, E, tid, bpre);
        } else if (ty == 6) {
            pool_phase(xo, SSQ + (size_t)(3 * L + 1) * M, PB, vcu, G, tid, wave, lane);
        } else if (ty == 7) {
            pg8::Gemm g{PB, (const bf16_t*)(ws + WS_WP) + (size_t)j * D * 256, D, 256, 256, 512};
            pg8::StaticOrder S; S.init(D, bx);
            pg8::EpiResid E{xo, o_f32, o_xb, nullptr, SSQ + (size_t)(dummy ? 14 : 3 * L + 2) * M};
            pg8::gemm_phase<pg8::EpiResid, true>(lds, g, S, E, tid, bpre);
        } else {
            final_phase(xo, SSQ + (size_t)12 * M, args.in[16], vcu, G, wave, lane);
        }
        }
#if !MK_PER_PHASE
        if (ph + 1 < hi) {
            if (ph == 0) {
                if (lo < 0) cg::this_grid().sync();
                xcd_barrier(bar);
                if (tid0 == 0) { unsigned ok = (G == 256) ? 1u : 0u;
                    unsigned all = 0u;
                    for (int gi = 0; gi < 8; ++gi) { const unsigned mk = xb_ld((unsigned*)(ws + WS_CTL) + CW_GMASK + 64 * gi); if (__builtin_popcount(mk) != 1) ok = 0u; all |= mk; }
                    if (__builtin_popcount(all) != 8) ok = 0u;
                    MISC[16] = ok; }
                __syncthreads();
                fast = (unsigned)__builtin_amdgcn_readfirstlane((int)MISC[16]);
                bpre = false;
            }
            else if (fast) {
                ++gb_epoch; group_barrier_arrive((unsigned*)(ws + WS_CTL), bx & 7);
                int nty, nL, ns; decode_phase(ph + 1, nty, nL, ns); const int nf = 2 * nL + ns, nj = nL >> 1;
                bpre = (nty == 1 || nty == 2 || nty == 3 || nty == 5 || nty == 7);
                if (bpre) {
                    int tidn = tid0; asm volatile("" : "+v"(tidn));
                    const bf16_t* nB; int nldb, nN;
                    if (nty == 1) { nB = (const bf16_t*)(ws + WS_WGU) + (size_t)nf * 2 * FF * D; nldb = D; nN = 2 * FF; }
                    else if (nty == 2) { nB = (const bf16_t*)(ws + WS_WD) + (size_t)nf * D * FF; nldb = FF; nN = D; }
                    else if (nty == 3) { nB = (const bf16_t*)(ws + WS_WIN) + (size_t)nj * 2 * D * D; nldb = D; nN = 2 * D; }
                    else if (nty == 5) { nB = (const bf16_t*)(ws + WS_WOUT) + (size_t)nj * D * D; nldb = D; nN = D; }
                    else { nB = (const bf16_t*)(ws + WS_WP) + (size_t)nj * D * 256; nldb = 256; nN = D; }
                    pg8::StaticOrder nS; nS.init(nN, bx); pg8::Unit nu; (void)nS.next(0, nu);
                    pg8::gemm_preissue_B(lds, nB, nldb, nu.pn, tidn);
                }
                group_barrier_wait((unsigned*)(ws + WS_CTL), bx & 7, gb_epoch * 32u);
            }
            else { bpre = false; xcd_barrier(bar); }
        }
#endif
    }
}

extern "C" void kernel_launch(void* const* d_in, const int* in_sizes, int n_in, void* d_out, int out_size, void* d_ws, size_t ws_size, hipStream_t stream) {
    static int grid = 0;
    if (grid == 0) {
        if (n_in != 17 || in_sizes[0] != M * D || out_size != M * D || ws_size < WS_END) { fprintf(stderr, "kernel_launch: unexpected shapes (n_in %d, in0 %d, out %d, ws %zu); nothing launched\n", n_in, n_in > 0 ? in_sizes[0] : -1, out_size, ws_size); grid = -1; return; }
        int dev = 0, cus = 0, per_cu = 0;
        if (hipGetDevice(&dev) != hipSuccess || hipDeviceGetAttribute(&cus, hipDeviceAttributeMultiprocessorCount, dev) != hipSuccess) { grid = -1; return; }
        if (hipFuncSetAttribute((const void*)trunk_fwd, hipFuncAttributeMaxDynamicSharedMemorySize, LDS_BYTES) != hipSuccess) { fprintf(stderr, "kernel_launch: hipFuncSetAttribute failed\n"); grid = -1; return; }
        if (hipOccupancyMaxActiveBlocksPerMultiprocessor(&per_cu, (const void*)trunk_fwd, NWAVES * 64, LDS_BYTES) != hipSuccess || per_cu < 1) { fprintf(stderr, "kernel_launch: occupancy query says %d blocks per CU\n", per_cu); per_cu = 1; }
        (void)hipGetLastError();
        grid = cus * (per_cu > 1 ? 1 : per_cu);
        if (grid != 256) { fprintf(stderr, "kernel_launch: this kernel's unit order is built for a 256-CU device (got %d); nothing launched\n", grid); grid = -1; return; }
    }
    if (grid < 0) return;
    if (hipMemsetAsync((char*)d_ws + WS_CTL, 0, CTL_ZERO_BYTES, stream) != hipSuccess) { fprintf(stderr, "kernel_launch: hipMemsetAsync failed\n"); return; }
    Args a{};
    for (int i = 0; i < 17; ++i) a.in[i] = (const float*)d_in[i];
    a.out = (float*)d_out; a.ws = (unsigned char*)d_ws;
#if MK_PER_PHASE
    for (int ph = 0; ph < 27; ++ph) { a.ph_lo = ph; a.ph_hi = ph + 1; hipLaunchKernelGGL(trunk_fwd, dim3(grid), dim3(NWAVES * 64), LDS_BYTES, stream, a); }
#else
    a.ph_lo = 0; a.ph_hi = 27;
    void* kargs[] = {&a};
    hipError_t e = hipLaunchCooperativeKernel((const void*)trunk_fwd, dim3(grid), dim3(NWAVES * 64), kargs, LDS_BYTES, stream);
    if (e != hipSuccess) fprintf(stderr, "kernel_launch: cooperative launch failed: %s (grid %d)\n", hipGetErrorString(e), grid);
#endif
}
```
